# Optimizing an MI355X kernel written in HIP

```python
import math
import jax, jax.numpy as jnp
from jax import lax
import numpy as np

D_MODEL = 1024
BATCH = 8
SEQ = 4096
DEPTH = 2

N_HEADS = 16
HEAD_DIM = D_MODEL // N_HEADS
D_FF = 4 * D_MODEL
N_MIXERS = 2
N_A_LAYERS = (DEPTH + 1) // 2
N_B_LAYERS = DEPTH // 2
NUM_BUCKETS = 32
MAX_DISTANCE = 128
MOBA_BLOCK = 256
MOBA_TOPK = 3
MOBA_Q_CHUNK = 64
DSA_Q_LORA = 256
DSA_KV_LORA = 256
IDX_HEADS = 8
IDX_DIM = 64
DSA_TOPK_MAX = 256
DSA_Q_CHUNK = 128
DSA_IN_DIM = DSA_Q_LORA + DSA_KV_LORA + IDX_DIM + IDX_HEADS
EPS = 1e-6
NEG = -1e30

kernel_name = "hybrid_moba_dsa_decoder"


def rms_norm(x, g):
    x32 = x.astype(jnp.float32)
    y = x32 * lax.rsqrt(jnp.mean(x32 * x32, axis=-1, keepdims=True) + EPS)
    return y.astype(x.dtype) * g


def rel_bucket(dist):
    n = jnp.maximum(dist, 0)
    exact = NUM_BUCKETS // 2
    nf = jnp.maximum(n, 1).astype(jnp.float32)
    large = exact + (jnp.log(nf / exact) / math.log(MAX_DISTANCE / exact) * (NUM_BUCKETS - exact)).astype(jnp.int32)
    large = jnp.minimum(large, NUM_BUCKETS - 1)
    return jnp.where(n < exact, n, large)


def moba_attention(h, w_qkv, w_o, bias_table):
    B, S, _ = h.shape
    H, Dh, BLK, QC = N_HEADS, HEAD_DIM, MOBA_BLOCK, MOBA_Q_CHUNK
    q, k, v = jnp.split(h @ w_qkv, 3, axis=-1)
    q = q.reshape(B, S, H, Dh).transpose(0, 2, 1, 3)
    k = k.reshape(B, S, H, Dh).transpose(0, 2, 1, 3)
    v = v.reshape(B, S, H, Dh).transpose(0, 2, 1, 3)
    n_blk = -(-S // BLK)
    pad = ((0, 0), (0, 0), (0, n_blk * BLK - S), (0, 0))
    kb = jnp.pad(k, pad).reshape(B, H, n_blk, BLK, Dh)
    vb = jnp.pad(v, pad).reshape(B, H, n_blk, BLK, Dh)
    k_mean = jnp.mean(kb.astype(jnp.float32), axis=3)
    gate = jnp.einsum('bhsd,bhnd->bhsn', q.astype(jnp.float32), k_mean)
    n_past = jnp.arange(S) // BLK
    past = jnp.arange(n_blk)[None, :] < n_past[:, None]
    gate = jnp.where(past[None, None], gate, NEG)
    k_sel = max(1, min(MOBA_TOPK, n_blk - 1))
    _, sel = lax.top_k(gate, k_sel)
    sel = sel.astype(jnp.int32)

    n_ch = S // QC

    def to_chunks(a):
        a = a.reshape(B, H, n_ch, QC, *a.shape[3:])
        a = jnp.moveaxis(a, 2, 1)
        return a.reshape(B * n_ch, H, QC, *a.shape[4:])

    q_c, sel_c = to_chunks(q), to_chunks(sel)
    b_idx = jnp.repeat(jnp.arange(B, dtype=jnp.int32), n_ch)
    c_idx = jnp.tile(jnp.arange(n_ch, dtype=jnp.int32), B)
    head_ids = jnp.arange(H)
    scale = HEAD_DIM ** -0.5

    def step(args):
        qc, selc, b, c = args
        t = c * QC + jnp.arange(QC, dtype=jnp.int32)
        j_own = (c * QC) // BLK
        kbb = lax.dynamic_index_in_dim(kb, b, 0, keepdims=False)
        vbb = lax.dynamic_index_in_dim(vb, b, 0, keepdims=False)
        k_g = kbb[head_ids[:, None, None], selc]
        v_g = vbb[head_ids[:, None, None], selc]
        k_own = lax.dynamic_index_in_dim(kbb, j_own, 1, keepdims=False)
        v_own = lax.dynamic_index_in_dim(vbb, j_own, 1, keepdims=False)
        qf = qc.astype(jnp.float32)
        l_sel = jnp.einsum('hqd,hqnjd->hqnj', qf, k_g.astype(jnp.float32)) * scale
        pos_sel = selc[..., None] * BLK + jnp.arange(BLK, dtype=jnp.int32)
        b_sel = bias_table[rel_bucket(t[None, :, None, None] - pos_sel), head_ids[:, None, None, None]].astype(jnp.float32)
        slot_ok = jnp.arange(k_sel)[None, :] < (t // BLK)[:, None]
        l_sel = jnp.where(slot_ok[None, :, :, None], l_sel + b_sel, NEG).reshape(H, QC, k_sel * BLK)
        l_own = jnp.einsum('hqd,hkd->hqk', qf, k_own.astype(jnp.float32)) * scale
        d_own = t[:, None] - (j_own * BLK + jnp.arange(BLK, dtype=jnp.int32))[None, :]
        b_own = jnp.moveaxis(bias_table[rel_bucket(d_own)].astype(jnp.float32), -1, 0)
        l_own = jnp.where((d_own >= 0)[None], l_own + b_own, NEG)
        p = jax.nn.softmax(jnp.concatenate([l_sel, l_own], axis=-1), axis=-1)
        p_sel = p[..., :k_sel * BLK].reshape(H, QC, k_sel, BLK)
        p_own = p[..., k_sel * BLK:]
        o = (jnp.einsum('hqnj,hqnjd->hqd', p_sel, v_g.astype(jnp.float32))
             + jnp.einsum('hqk,hkd->hqd', p_own, v_own.astype(jnp.float32)))
        return o.astype(qc.dtype)

    o = lax.map(step, (q_c, sel_c, b_idx, c_idx))
    o = o.reshape(B, n_ch, H, QC, Dh).transpose(0, 1, 3, 2, 4).reshape(B, S, H * Dh)
    return o @ w_o


def dsa_attention(h, w_in, g_q, g_kv, w_uq, w_qi, w_uk, w_uv, w_o, bias_table):
    B, S, _ = h.shape
    H, Dh, QC = N_HEADS, HEAD_DIM, DSA_Q_CHUNK
    proj = h @ w_in
    c_q, c_kv, k_idx, w_idx = jnp.split(proj, [DSA_Q_LORA, DSA_Q_LORA + DSA_KV_LORA, DSA_Q_LORA + DSA_KV_LORA + IDX_DIM], axis=-1)
    c_q = rms_norm(c_q, g_q)
    c_kv = rms_norm(c_kv, g_kv)
    q_nope = (c_q @ w_uq).reshape(B, S, H, Dh)
    q_idx = (c_q @ w_qi).reshape(B, S, IDX_HEADS, IDX_DIM)
    w_idx = w_idx.astype(jnp.float32) * (IDX_HEADS ** -0.5 * IDX_DIM ** -0.5)
    top_k = min(DSA_TOPK_MAX, S // 4)
    n_ch = S // QC

    def to_chunks(a):
        return jnp.moveaxis(a.reshape(B, n_ch, QC, *a.shape[2:]), 1, 0)

    k_idx32 = k_idx.astype(jnp.float32)
    key_pos = jnp.arange(S, dtype=jnp.int32)
    b_ids = jnp.arange(B)[:, None, None]
    scale = HEAD_DIM ** -0.5

    def step(args):
        qn, qi, wi, c = args
        t = c * QC + jnp.arange(QC, dtype=jnp.int32)
        rel = jax.nn.relu(jnp.einsum('bqhd,bsd->bqhs', qi.astype(jnp.float32), k_idx32))
        score = jnp.einsum('bqh,bqhs->bqs', wi, rel)
        score = jnp.where((key_pos[None, :] <= t[:, None])[None], score, NEG)
        _, idx = lax.top_k(score, top_k)
        valid = idx <= t[None, :, None]
        c_sel = c_kv[b_ids, idx].astype(jnp.float32)
        q_lat = jnp.einsum('bqhd,hdc->bqhc', qn.astype(jnp.float32), w_uk.astype(jnp.float32))
        logits = jnp.einsum('bqhc,bqkc->bhqk', q_lat, c_sel) * scale
        bias = jnp.moveaxis(bias_table[rel_bucket(t[None, :, None] - idx)].astype(jnp.float32), -1, 1)
        logits = jnp.where(valid[:, None], logits + bias, NEG)
        p = jax.nn.softmax(logits, axis=-1)
        o_lat = jnp.einsum('bhqk,bqkc->bqhc', p, c_sel)
        o = jnp.einsum('bqhc,hcd->bqhd', o_lat, w_uv.astype(jnp.float32))
        return o.astype(qn.dtype)

    o = lax.map(step, (to_chunks(q_nope), to_chunks(q_idx), to_chunks(w_idx), jnp.arange(n_ch, dtype=jnp.int32)))
    o = jnp.moveaxis(o, 0, 1).reshape(B, S, H * Dh)
    return o @ w_o


def sq_relu_mlp(h, w_up, w_down):
    return jnp.square(jax.nn.relu(h @ w_up)) @ w_down


def setup_inputs(seed: int = 0) -> dict:
    key = jax.random.key(seed)
    ks = jax.random.split(key, 20)
    D, H, Dh = D_MODEL, N_HEADS, HEAD_DIM
    nrm = lambda k, shape, s: jax.random.normal(k, shape, jnp.float32) * s
    gain = lambda k, shape: 1.0 + 0.05 * jax.random.normal(k, shape, jnp.float32)
    return {
        "x": nrm(ks[0], (BATCH, SEQ, D), 1.0),
        "rel_bias": nrm(ks[1], (NUM_BUCKETS, H), 0.2),
        "ln_attn": gain(ks[2], (DEPTH, D)),
        "ln_mlp": gain(ks[3], (DEPTH, D)),
        "moba_w_qkv": nrm(ks[4], (N_A_LAYERS, D, 3 * D), D ** -0.5),
        "moba_w_o": nrm(ks[5], (N_A_LAYERS, D, D), D ** -0.5),
        "dsa_w_in": nrm(ks[6], (N_B_LAYERS, D, DSA_IN_DIM), D ** -0.5),
        "dsa_g_q": gain(ks[7], (N_B_LAYERS, DSA_Q_LORA)),
        "dsa_g_kv": gain(ks[8], (N_B_LAYERS, DSA_KV_LORA)),
        "dsa_w_uq": nrm(ks[9], (N_B_LAYERS, DSA_Q_LORA, H * Dh), DSA_Q_LORA ** -0.5),
        "dsa_w_qi": nrm(ks[10], (N_B_LAYERS, DSA_Q_LORA, IDX_HEADS * IDX_DIM), DSA_Q_LORA ** -0.5),
        "dsa_w_uk": nrm(ks[11], (N_B_LAYERS, H, Dh, DSA_KV_LORA), DSA_KV_LORA ** -0.5),
        "dsa_w_uv": nrm(ks[12], (N_B_LAYERS, H, DSA_KV_LORA, Dh), DSA_KV_LORA ** -0.5),
        "dsa_w_o": nrm(ks[13], (N_B_LAYERS, H * Dh, D), (H * Dh) ** -0.5),
        "mlp_w_up": nrm(ks[14], (DEPTH, D, D_FF), D ** -0.5),
        "mlp_w_down": nrm(ks[15], (DEPTH, D_FF, D), 0.5 * D_FF ** -0.5),
        "final_norm": gain(ks[16], (D,)),
    }


def reference(x, rel_bias, ln_attn, ln_mlp, moba_w_qkv, moba_w_o, dsa_w_in, dsa_g_q, dsa_g_kv,
              dsa_w_uq, dsa_w_qi, dsa_w_uk, dsa_w_uv, dsa_w_o, mlp_w_up, mlp_w_down, final_norm):
    for i in range(DEPTH):
        hn = rms_norm(x, ln_attn[i])
        j = i // N_MIXERS
        if i % N_MIXERS == 0:
            x = x + moba_attention(hn, moba_w_qkv[j], moba_w_o[j], rel_bias)
        else:
            x = x + dsa_attention(hn, dsa_w_in[j], dsa_g_q[j], dsa_g_kv[j], dsa_w_uq[j], dsa_w_qi[j],
                                  dsa_w_uk[j], dsa_w_uv[j], dsa_w_o[j], rel_bias)
        x = x + sq_relu_mlp(rms_norm(x, ln_mlp[i]), mlp_w_up[i], mlp_w_down[i])
    return rms_norm(x, final_norm)
```

```cpp
#include <hip/hip_runtime.h>
#include <cstdio>
#include <cstdint>

constexpr int NB = 8, SEQ = 4096, DM = 1024, NH = 16, HD = 64, FF = 4096;
constexpr int T = NB * SEQ;
constexpr int MBLK = 256, NBLK = SEQ / MBLK;
constexpr int DQ = 256, DC = 256, IH = 8, ID = 64;
constexpr int DSA_IN = DQ + DC + ID + IH;
constexpr int DSA_IN_PAD = 768;
constexpr int TOPK = 256;
constexpr float EPS = 1e-6f;
constexpr float LOG2E = 1.4426950408889634f;
constexpr float C2 = 0.125f * LOG2E;

constexpr size_t MiB = 1u << 20;
constexpr size_t WS_CTL = 0, CTL_ZERO_BYTES = 1 * MiB;
constexpr size_t WS_WQKV0 = 1 * MiB, WS_WO0 = 7 * MiB, WS_WUP0 = 9 * MiB, WS_WDN0 = 17 * MiB, WS_WIN1 = 25 * MiB, WS_WQ1 = 27 * MiB,
                 WS_WOV1 = 30 * MiB, WS_WUP1 = 38 * MiB, WS_WDN1 = 46 * MiB;
constexpr size_t WS_SSP = 54 * MiB;
constexpr size_t WS_KSUM = 56 * MiB;
constexpr size_t WS_LUT = 57 * MiB;
constexpr size_t WS_XB = 58 * MiB;
constexpr size_t WS_CQ = 122 * MiB;
constexpr size_t WS_CKVN = 138 * MiB;
constexpr size_t WS_KIDX = 154 * MiB;
constexpr size_t WS_WIDX = 158 * MiB;
constexpr size_t WS_SSQ = 159 * MiB;
constexpr size_t WS_QIDX = 160 * MiB;
constexpr size_t WS_MASK = 192 * MiB;
constexpr size_t WS_CKV = 208 * MiB;
constexpr size_t WS_BIG = 240 * MiB;
constexpr size_t WS_END = 496 * MiB;

typedef unsigned short bf16_t;
typedef float f32x4 __attribute__((ext_vector_type(4)));
typedef float f32x2 __attribute__((ext_vector_type(2)));
typedef unsigned u32x4 __attribute__((ext_vector_type(4)));
typedef unsigned u32x2 __attribute__((ext_vector_type(2)));
typedef short bf16x8 __attribute__((ext_vector_type(8)));
#define GAS __attribute__((address_space(1)))
#define LAS __attribute__((address_space(3)))

__device__ __forceinline__ unsigned f2bf(float f) { unsigned u = __builtin_bit_cast(unsigned, f); return (u + 0x7fffu + ((u >> 16) & 1u)) >> 16; }
__device__ __forceinline__ unsigned pk2(float lo, float hi) { return f2bf(lo) | (f2bf(hi) << 16); }
__device__ __forceinline__ float bf2f(unsigned h) { return __builtin_bit_cast(float, h << 16); }
__device__ __forceinline__ float bflo(unsigned w) { return __builtin_bit_cast(float, w << 16); }
__device__ __forceinline__ float bfhi(unsigned w) { return __builtin_bit_cast(float, w & 0xffff0000u); }

__device__ const unsigned char BUCKET_TAB[128] = {0,1,2,3,4,5,6,7,8,9,10,11,12,13,14,15,16,16,16,17,17,18,18,18,19,19,19,20,20,20,20,21,21,21,21,22,22,22,22,22,23,23,23,23,23,23,24,24,24,24,24,24,25,25,25,25,25,25,25,26,26,26,26,26,26,26,26,27,27,27,27,27,27,27,27,27,27,28,28,28,28,28,28,28,28,28,28,29,29,29,29,29,29,29,29,29,29,29,29,30,30,30,30,30,30,30,30,30,30,30,30,30,30,31,31,31,31,31,31,31,31,31,31,31,31,31,31,31};

__device__ __forceinline__ float sumsq4(const f32x4 a) { return (a[0] * a[0] + a[1] * a[1]) + (a[2] * a[2] + a[3] * a[3]); }

namespace pg8 {
#define PG8_LAS __attribute__((address_space(3)))
typedef unsigned short bf16_t;
typedef short bf16x8 __attribute__((ext_vector_type(8)));
typedef float f32x4 __attribute__((ext_vector_type(4)));
typedef unsigned u32x4 __attribute__((ext_vector_type(4)));
constexpr int BM = 256, BK = 64, HALF = 128, HTB = HALF * BK * 2  , STAGE_BYTES = 8 * HTB, NXCD = 8, WGM = 8;

__host__ __device__ __forceinline__ int lds_byte(int r, int c) { const int st = (r >> 4) * 2 + (c >> 5), rr = r & 15, cc = c & 31, ob = rr * 64 + cc * 2; return st * 1024 + (ob ^ (((ob >> 9) & 1) << 5)); }
__host__ __device__ __forceinline__ void stage_rc(int b, int& R, int& C) { const int st = b / 1024, sb = b % 1024, swz = sb ^ (((sb >> 9) & 1) << 5); R = (st >> 1) * 16 + swz / 64; C = (st & 1) * 32 + (swz % 64) / 2; }
__host__ __device__ __forceinline__ int perm32(int rho) { const int n = rho >> 4, i = rho & 15; return 8 * (i >> 2) + 4 * n + (i & 3); }

struct Unit { int pm, pn; };
struct Gemm { const bf16_t* A; const bf16_t* Bt; int M, N, K; };

struct StaticOrder {
    int nM, nN, nwg, G, c;
    __host__ __device__ void init(int M, int N, int G_, int c_) { nM = M / BM; nN = N / BM; nwg = nM * nN; G = G_; c = c_; }
    __host__ __device__ bool next(int i, Unit& u) const {
        const long L = (long)i * G + c; if (L >= nwg) return false;
        int wgid = (int)L; { const int q = nwg / NXCD, r = nwg % NXCD, xcd = wgid % NXCD, off = wgid / NXCD; wgid = (xcd < r ? xcd * (q + 1) : r * (q + 1) + (xcd - r) * q) + off; }
        const int nig = WGM * nN, gid = wgid / nig, fm = gid * WGM, gsz = (nM - fm) < WGM ? (nM - fm) : WGM;
        u.pm = fm + ((wgid % nig) % gsz); u.pn = (wgid % nig) / gsz; return true;
    }
    __device__ __forceinline__ void a_ready(const Unit&) const {}
    __device__ __forceinline__ void done(const Unit&) const {}
};


__device__ __forceinline__ unsigned cvt_pk_bf16(float lo, float hi) { unsigned r; asm volatile("v_cvt_pk_bf16_f32 %0, %1, %2" : "=v"(r) : "v"(lo), "v"(hi)); return r; }
__device__ __forceinline__ u32x4 pack8(const f32x4 a, const f32x4 b) { u32x4 w; w.x = cvt_pk_bf16(a[0], a[1]); w.y = cvt_pk_bf16(a[2], a[3]); w.z = cvt_pk_bf16(b[0], b[1]); w.w = cvt_pk_bf16(b[2], b[3]); return w; }
__device__ __forceinline__ float row_rstd16(const float* ssp, int row) {
    const f32x4* p = (const f32x4*)(ssp + (size_t)row * 16); const f32x4 a = p[0], b = p[1], c = p[2], d = p[3];
    const float s = ((a[0] + a[1]) + (a[2] + a[3])) + ((b[0] + b[1]) + (b[2] + b[3])) + ((c[0] + c[1]) + (c[2] + c[3])) + ((d[0] + d[1]) + (d[2] + d[3]));
    return 1.0f / sqrtf(s * (1.0f / 1024.0f) + EPS);
}

struct EpiQKV {
    static constexpr bool PERM = true, AFTER_DRAIN = false;
    bf16_t* Q; const float* ssp; float* ksum;
    __device__ __forceinline__ void operator()(const f32x4 (&acc)[2][2][4][2], const Unit& u, int wr, int wc, int fr, int fq) const {
        const int row0 = u.pm * BM + wr * 64 + fr; int colt = u.pn * BM; const int t = colt >> 10; colt &= 1023;
        bf16_t* base = Q + (size_t)t * T * DM; const float sc = (t == 0) ? C2 : 1.0f;
        const int col0 = colt + wc * 32 + 8 * fq;
        f32x4 cs[2][2];
#pragma unroll
        for (int bj = 0; bj < 2; ++bj)
#pragma unroll
            for (int n = 0; n < 2; ++n) cs[bj][n] = (f32x4){0.f, 0.f, 0.f, 0.f};
#pragma unroll
        for (int ai = 0; ai < 2; ++ai)
#pragma unroll
            for (int m = 0; m < 4; ++m) { const int row = row0 + ai * HALF + m * 16; const float rs = row_rstd16(ssp, row) * sc; bf16_t* rowp = base + (size_t)row * DM + col0;
#pragma unroll
                for (int bj = 0; bj < 2; ++bj) { const f32x4 v0 = acc[ai][bj][m][0] * rs, v1 = acc[ai][bj][m][1] * rs; cs[bj][0] += v0; cs[bj][1] += v1;
                    *(u32x4*)(rowp + bj * HALF) = pack8(v0, v1); } }
        if (t == 1) {
#pragma unroll
            for (int bj = 0; bj < 2; ++bj)
#pragma unroll
                for (int n = 0; n < 2; ++n) { f32x4 s = cs[bj][n];
#pragma unroll
                    for (int o = 1; o < 16; o <<= 1) { s[0] += __shfl_xor(s[0], o); s[1] += __shfl_xor(s[1], o); s[2] += __shfl_xor(s[2], o); s[3] += __shfl_xor(s[3], o); }
                    if (fr == 0) *(f32x4*)(ksum + ((size_t)(u.pm * 2 + wr)) * DM + col0 + bj * HALF + 4 * n) = s; }
        }
    }
};
struct EpiRes {
    static constexpr bool PERM = true, AFTER_DRAIN = false;
    const float* base; float* X; bf16_t* XB; float* ssp;
    __device__ __forceinline__ void operator()(const f32x4 (&acc)[2][2][4][2], const Unit& u, int wr, int wc, int fr, int fq) const {
        const int row0 = u.pm * BM + wr * 64 + fr; const int col0 = u.pn * BM + wc * 32 + 8 * fq;
#pragma unroll
        for (int ai = 0; ai < 2; ++ai)
#pragma unroll
            for (int m = 0; m < 4; ++m) { const int row = row0 + ai * HALF + m * 16; const size_t off = (size_t)row * DM + col0; float ss = 0.f;
#pragma unroll
                for (int bj = 0; bj < 2; ++bj) { const f32x4 b0 = *(const f32x4*)(base + off + bj * HALF), b1 = *(const f32x4*)(base + off + bj * HALF + 4);
                    const f32x4 v0 = b0 + acc[ai][bj][m][0], v1 = b1 + acc[ai][bj][m][1];
                    *(f32x4*)(X + off + bj * HALF) = v0; *(f32x4*)(X + off + bj * HALF + 4) = v1; *(u32x4*)(XB + off + bj * HALF) = pack8(v0, v1);
                    ss += sumsq4(v0) + sumsq4(v1); }
                ss += __shfl_xor(ss, 16); ss += __shfl_xor(ss, 32);
                if (fq == 0) ssp[(size_t)row * 16 + u.pn * 4 + wc] = ss; }
    }
};
struct EpiUp {
    static constexpr bool PERM = true, AFTER_DRAIN = false;
    bf16_t* U; const float* ssp;
    __device__ __forceinline__ void operator()(const f32x4 (&acc)[2][2][4][2], const Unit& u, int wr, int wc, int fr, int fq) const {
        const int row0 = u.pm * BM + wr * 64 + fr; const int col0 = u.pn * BM + wc * 32 + 8 * fq;
#pragma unroll
        for (int ai = 0; ai < 2; ++ai)
#pragma unroll
            for (int m = 0; m < 4; ++m) { const int row = row0 + ai * HALF + m * 16; const float rs = row_rstd16(ssp, row); bf16_t* rowp = U + (size_t)row * FF + col0;
#pragma unroll
                for (int bj = 0; bj < 2; ++bj) { f32x4 v0 = acc[ai][bj][m][0] * rs, v1 = acc[ai][bj][m][1] * rs;
                    v0 = __builtin_elementwise_max(v0, (f32x4){0.f, 0.f, 0.f, 0.f}); v1 = __builtin_elementwise_max(v1, (f32x4){0.f, 0.f, 0.f, 0.f}); v0 = v0 * v0; v1 = v1 * v1;
                    *(u32x4*)(rowp + bj * HALF) = pack8(v0, v1); } }
    }
};
struct EpiDsaIn {
    static constexpr bool PERM = true, AFTER_DRAIN = false;
    bf16_t* CQ; float* CKV; bf16_t* KIDX; float* WIDX; float* ssq; const float* ssp;
    __device__ __forceinline__ void operator()(const f32x4 (&acc)[2][2][4][2], const Unit& u, int wr, int wc, int fr, int fq) const {
        const int row0 = u.pm * BM + wr * 64 + fr; const int c0 = wc * 32 + 8 * fq;
#pragma unroll
        for (int ai = 0; ai < 2; ++ai)
#pragma unroll
            for (int m = 0; m < 4; ++m) { const int row = row0 + ai * HALF + m * 16; const float rs = row_rstd16(ssp, row);
                f32x4 v[2][2];
#pragma unroll
                for (int bj = 0; bj < 2; ++bj) { v[bj][0] = acc[ai][bj][m][0] * rs; v[bj][1] = acc[ai][bj][m][1] * rs; }
                if (u.pn < 2) {
                    float ss = (sumsq4(v[0][0]) + sumsq4(v[0][1])) + (sumsq4(v[1][0]) + sumsq4(v[1][1]));
                    ss += __shfl_xor(ss, 16); ss += __shfl_xor(ss, 32);
                    if (fq == 0) ssq[(size_t)row * 8 + u.pn * 4 + wc] = ss;
                    if (u.pn == 0) {
#pragma unroll
                        for (int bj = 0; bj < 2; ++bj) *(u32x4*)(CQ + (size_t)row * DQ + c0 + bj * HALF) = pack8(v[bj][0], v[bj][1]);
                    } else {
#pragma unroll
                        for (int bj = 0; bj < 2; ++bj) { *(f32x4*)(CKV + (size_t)row * DC + c0 + bj * HALF) = v[bj][0]; *(f32x4*)(CKV + (size_t)row * DC + c0 + bj * HALF + 4) = v[bj][1]; }
                    }
                } else {
                    if (wc < 2) *(u32x4*)(KIDX + (size_t)row * ID + c0) = pack8(v[0][0], v[0][1]);
                    else if (wc == 2 && fq == 0) { const float ws = 0.04419417382415922f;
                        *(f32x4*)(WIDX + (size_t)row * IH) = v[0][0] * ws; *(f32x4*)(WIDX + (size_t)row * IH + 4) = v[0][1] * ws; }
                }
            }
    }
};
struct EpiDsaQ {
    static constexpr bool PERM = true, AFTER_DRAIN = false;
    bf16_t* QLAT; bf16_t* QIDX; const float* ssq;
    __device__ __forceinline__ void operator()(const f32x4 (&acc)[2][2][4][2], const Unit& u, int wr, int wc, int fr, int fq) const {
        const int row0 = u.pm * BM + wr * 64 + fr; int colt = u.pn * BM; bf16_t* base; int ld;
        if (colt < 4096) { base = QLAT; ld = 4096; } else { base = QIDX; ld = 512; colt -= 4096; }
        const int col0 = colt + wc * 32 + 8 * fq;
#pragma unroll
        for (int ai = 0; ai < 2; ++ai)
#pragma unroll
            for (int m = 0; m < 4; ++m) { const int row = row0 + ai * HALF + m * 16; const f32x4 p = *(const f32x4*)(ssq + (size_t)row * 8);
                const float rs = 1.0f / sqrtf(((p[0] + p[1]) + (p[2] + p[3])) * (1.0f / 256.0f) + EPS); bf16_t* rowp = base + (size_t)row * ld + col0;
#pragma unroll
                for (int bj = 0; bj < 2; ++bj) *(u32x4*)(rowp + bj * HALF) = pack8(acc[ai][bj][m][0] * rs, acc[ai][bj][m][1] * rs); }
    }
};

template <class Epi, class Sched, bool ALIGN_EPI = false, bool SP2 = false>
__device__ __forceinline__ void gemm_phase(PG8_LAS unsigned char* lds, const Gemm g, const Sched& S, const Epi& E) {
    const int tid = threadIdx.x, wid = __builtin_amdgcn_readfirstlane(tid >> 6), lane = tid & 63, wr = wid >> 2, wc = wid & 3, fr = lane & 15, fq = lane >> 4;
    const int K = g.K, nt = K / BK;
    unsigned voffA[2], voffB[2];
#pragma unroll
    for (int i = 0; i < 2; ++i) { int R, C; stage_rc(tid * 16 + i * 8192, R, C); const int Rb = Epi::PERM ? ((R & ~31) + perm32(R & 31)) : R;
        voffA[i] = (unsigned)(R * K + C) * 2u; voffB[i] = (unsigned)(Rb * K + C) * 2u; }
    const size_t kstep = (size_t)(BK * 2);
    const size_t hstep = (size_t)HALF * K * 2;
    const size_t tstep = 2 * hstep;
    const unsigned ldsw = (unsigned)wid * 1024u;
    const int aoff = lds_byte(wr * 64 + fr, fq * 8), boff = lds_byte(wc * 32 + fr, fq * 8);
#define PG8_SA(b, h) (((b) * 2 + (h)) * HTB)
#define PG8_SB(b, h) ((4 + (b) * 2 + (h)) * HTB)
#define PG8_STAGE(bufoff, gbase, voff) do { _Pragma("unroll") for (int _i = 0; _i < 2; ++_i) \
        __builtin_amdgcn_global_load_lds((const unsigned*)((const char*)(gbase) + (voff)[_i]), (PG8_LAS unsigned*)(lds + (bufoff) + ldsw + _i * 8192), 16, 0, 0); } while (0)
#define PG8_LDA(dst, b, h) do { _Pragma("unroll") for (int m = 0; m < 4; ++m) _Pragma("unroll") for (int k = 0; k < 2; ++k) dst[m][k] = *(const PG8_LAS bf16x8*)(lds + PG8_SA(b, h) + aoff + m * 2048 + k * 1024); } while (0)
#define PG8_LDB(dst, b, h) do { _Pragma("unroll") for (int n = 0; n < 2; ++n) _Pragma("unroll") for (int k = 0; k < 2; ++k) dst[n][k] = *(const PG8_LAS bf16x8*)(lds + PG8_SB(b, h) + boff + n * 2048 + k * 1024); } while (0)
#define PG8_MMA(ai, bj, At, Bt) do { __builtin_amdgcn_s_setprio(1); _Pragma("unroll") for (int m = 0; m < 4; ++m) _Pragma("unroll") for (int n = 0; n < 2; ++n) _Pragma("unroll") for (int k = 0; k < 2; ++k) \
        acc[ai][bj][m][n] = __builtin_amdgcn_mfma_f32_16x16x32_bf16(Bt[n][k], At[m][k], acc[ai][bj][m][n], 0, 0, 0); __builtin_amdgcn_s_setprio(0); } while (0)
#define PG8_WAIT_V(n) asm volatile("s_waitcnt vmcnt(" #n ")" ::: "memory")
#define PG8_WAIT_L(n) asm volatile("s_waitcnt lgkmcnt(" #n ")" ::: "memory")
#define PG8_BAR __builtin_amdgcn_s_barrier()
#define PG8_SCHED __builtin_amdgcn_sched_barrier(0)
    Unit cur, nxt; int ui = 0;
    if (!S.next(0, cur)) return;
    f32x4 acc[2][2][4][2];
#pragma unroll
    for (int a = 0; a < 2; ++a)
#pragma unroll
        for (int b = 0; b < 2; ++b)
#pragma unroll
            for (int m = 0; m < 4; ++m)
#pragma unroll
                for (int n = 0; n < 2; ++n) acc[a][b][m][n] = (f32x4){0.f, 0.f, 0.f, 0.f};
    bf16x8 At[4][2], B0[2][2], B1[2][2];
    const char* cA = (const char*)g.A + (size_t)cur.pm * tstep; const char* cB = (const char*)g.Bt + (size_t)cur.pn * tstep;
    S.a_ready(cur);
    if constexpr (SP2) {
        PG8_STAGE(PG8_SB(0, 0), cB, voffB); PG8_STAGE(PG8_SB(0, 1), cB + hstep, voffB); PG8_STAGE(PG8_SA(0, 0), cA, voffA); PG8_STAGE(PG8_SA(0, 1), cA + hstep, voffA);
        if (wr == 1) PG8_BAR;
        PG8_WAIT_V(2); PG8_BAR;
        PG8_STAGE(PG8_SB(1, 0), cB + kstep, voffB); PG8_STAGE(PG8_SA(1, 0), cA + kstep, voffA); PG8_STAGE(PG8_SB(1, 1), cB + hstep + kstep, voffB);
        PG8_WAIT_V(6); PG8_BAR;
    } else {
        PG8_STAGE(PG8_SB(0, 0), cB, voffB); PG8_STAGE(PG8_SA(0, 0), cA, voffA); PG8_STAGE(PG8_SB(0, 1), cB + hstep, voffB); PG8_STAGE(PG8_SA(0, 1), cA + hstep, voffA);
        if (wr == 1) PG8_BAR;
        PG8_WAIT_V(4); PG8_BAR;
        PG8_STAGE(PG8_SB(1, 0), cB + kstep, voffB); PG8_STAGE(PG8_SA(1, 0), cA + kstep, voffA); PG8_STAGE(PG8_SB(1, 1), cB + hstep + kstep, voffB);
        PG8_WAIT_V(6); PG8_BAR;
    }
    for (;;) {
        const bool has_next = S.next(ui + 1, nxt);
        const char* nA = has_next ? (const char*)g.A + (size_t)nxt.pm * tstep : cA; const char* nB = has_next ? (const char*)g.Bt + (size_t)nxt.pn * tstep : cB;
        for (int t = 0; t < nt; t += 2) {
            const bool last = (t == nt - 2);
            const char* a1 = cA + (size_t)(t + 1) * kstep;
            const char* a2 = last ? nA : cA + (size_t)(t + 2) * kstep; const char* b2 = last ? nB : cB + (size_t)(t + 2) * kstep;
            const char* a3 = a2 + kstep; const char* b3 = b2 + kstep;
            if (last && has_next) S.a_ready(nxt);
            if constexpr (SP2) {
            PG8_LDB(B0, 0, 0); PG8_LDB(B1, 0, 1); PG8_SCHED; PG8_LDA(At, 0, 0); PG8_STAGE(PG8_SA(1, 1), a1 + hstep, voffA);
            PG8_WAIT_V(8); PG8_WAIT_L(0); PG8_BAR; PG8_MMA(0, 0, At, B0); PG8_MMA(0, 1, At, B1); PG8_BAR; PG8_SCHED;
            PG8_LDA(At, 0, 1); PG8_STAGE(PG8_SB(0, 0), b2, voffB); PG8_STAGE(PG8_SB(0, 1), b2 + hstep, voffB); PG8_STAGE(PG8_SA(0, 0), a2, voffA);
            PG8_WAIT_V(8); PG8_WAIT_L(0); PG8_BAR; PG8_MMA(1, 0, At, B0); PG8_MMA(1, 1, At, B1); PG8_BAR; PG8_SCHED;
            PG8_LDB(B0, 1, 0); PG8_LDB(B1, 1, 1); PG8_SCHED; PG8_LDA(At, 1, 0); PG8_STAGE(PG8_SA(0, 1), a2 + hstep, voffA);
            PG8_WAIT_V(8); PG8_WAIT_L(0); PG8_BAR; PG8_MMA(0, 0, At, B0); PG8_MMA(0, 1, At, B1); PG8_BAR; PG8_SCHED;
            PG8_LDA(At, 1, 1); PG8_STAGE(PG8_SB(1, 0), b3, voffB); PG8_STAGE(PG8_SB(1, 1), b3 + hstep, voffB); PG8_STAGE(PG8_SA(1, 0), a3, voffA);
            PG8_WAIT_V(8); PG8_WAIT_L(0); PG8_BAR; PG8_MMA(1, 0, At, B0); PG8_MMA(1, 1, At, B1); PG8_BAR; PG8_SCHED;
            } else {
            PG8_LDB(B0, 0, 0); PG8_SCHED; PG8_LDA(At, 0, 0); PG8_STAGE(PG8_SA(1, 1), a1 + hstep, voffA);
            PG8_WAIT_L(8); PG8_BAR; PG8_WAIT_L(0); PG8_MMA(0, 0, At, B0); PG8_BAR; PG8_SCHED;
            PG8_LDB(B1, 0, 1); PG8_STAGE(PG8_SB(0, 0), b2, voffB);
            PG8_BAR; PG8_WAIT_L(0); PG8_MMA(0, 1, At, B1); PG8_BAR;
            PG8_LDA(At, 0, 1); PG8_STAGE(PG8_SA(0, 0), a2, voffA);
            PG8_BAR; PG8_WAIT_L(0); PG8_MMA(1, 0, At, B0); PG8_BAR; PG8_SCHED;
            PG8_STAGE(PG8_SB(0, 1), b2 + hstep, voffB);
            PG8_WAIT_V(6); PG8_BAR; PG8_MMA(1, 1, At, B1); PG8_BAR;
            PG8_LDB(B0, 1, 0); PG8_SCHED; PG8_LDA(At, 1, 0); PG8_STAGE(PG8_SA(0, 1), a2 + hstep, voffA);
            PG8_WAIT_L(8); PG8_BAR; PG8_WAIT_L(0); PG8_MMA(0, 0, At, B0); PG8_BAR; PG8_SCHED;
            PG8_LDB(B1, 1, 1); PG8_STAGE(PG8_SB(1, 0), b3, voffB);
            PG8_BAR; PG8_WAIT_L(0); PG8_MMA(0, 1, At, B1); PG8_BAR;
            PG8_LDA(At, 1, 1); PG8_STAGE(PG8_SA(1, 0), a3, voffA);
            PG8_BAR; PG8_WAIT_L(0); PG8_MMA(1, 0, At, B0); PG8_BAR; PG8_SCHED;
            PG8_STAGE(PG8_SB(1, 1), b3 + hstep, voffB);
            PG8_WAIT_V(6); PG8_BAR; PG8_MMA(1, 1, At, B1); PG8_BAR;
            }
        }
        if constexpr (ALIGN_EPI) { if (wr == 0) PG8_BAR; }
        if constexpr (!Epi::AFTER_DRAIN) { E(acc, cur, wr, wc, fr, fq); S.done(cur); }
        if (!has_next) break;
#pragma unroll
        for (int a = 0; a < 2; ++a)
#pragma unroll
            for (int b = 0; b < 2; ++b)
#pragma unroll
                for (int m = 0; m < 4; ++m)
#pragma unroll
                    for (int n = 0; n < 2; ++n) acc[a][b][m][n] = (f32x4){0.f, 0.f, 0.f, 0.f};
        cur = nxt; cA = nA; cB = nB; ++ui;
        if constexpr (ALIGN_EPI) { if (wr == 1) PG8_BAR; }
    }
    PG8_WAIT_V(0);
    if constexpr (!ALIGN_EPI) { if (wr == 0) PG8_BAR; }
    PG8_BAR;
    if constexpr (Epi::AFTER_DRAIN) { E.fused(acc, cur, wr, wc, fr, fq, lds, wid, lane); S.done(cur); }
#undef PG8_SA
#undef PG8_SB
#undef PG8_STAGE
#undef PG8_LDA
#undef PG8_LDB
#undef PG8_MMA
#undef PG8_WAIT_V
#undef PG8_WAIT_L
#undef PG8_BAR
#undef PG8_SCHED
}
}


struct Params {
    const float* x; const float* rel_bias; const float* ln_attn; const float* ln_mlp; const float* moba_w_qkv; const float* moba_w_o; const float* dsa_w_in; const float* dsa_g_q; const float* dsa_g_kv;
    const float* dsa_w_uq; const float* dsa_w_qi; const float* dsa_w_uk; const float* dsa_w_uv; const float* dsa_w_o; const float* mlp_w_up; const float* mlp_w_down; const float* final_norm;
    float* out; unsigned char* ws;
};
constexpr int NWAVES = 8, NTHR = NWAVES * 64;
constexpr int RING_BYTES = 131072;
constexpr int LDS_BYTES = 147456;

__device__ __forceinline__ float wave_sum(float v) {
#pragma unroll
    for (int o = 1; o < 64; o <<= 1) v += __shfl_xor(v, o);
    return v;
}
__device__ __forceinline__ float wave_max(float v) {
#pragma unroll
    for (int o = 1; o < 64; o <<= 1) v = fmaxf(v, __shfl_xor(v, o));
    return v;
}

__device__ __forceinline__ void p0_transpose_item(const float* W, const float* gain, int K, int N, int Npad, bf16_t* WT, int row_off, LAS float* scr, int item, int lane) {
    const int nblk = Npad / 32, kb = item / nblk, nb = item % nblk, k0 = 64 * kb, n0 = 32 * nb;
#pragma unroll 8
    for (int i = 0; i < 32; ++i) { const int kk = 2 * i + (lane >> 5); const int n = n0 + (lane & 31);
        float v = (n < N) ? W[(size_t)(k0 + kk) * N + n] : 0.f; if (gain) v *= gain[k0 + kk]; scr[kk * 33 + (lane & 31)] = v; }
    asm volatile("s_waitcnt lgkmcnt(0)" ::: "memory");
    const int c = lane & 7;
#pragma unroll
    for (int j = 0; j < 4; ++j) { const int n = (lane >> 3) + 8 * j; const LAS float* s = scr + (8 * c) * 33 + n;
        u32x4 o; o.x = pk2(s[0 * 33], s[1 * 33]); o.y = pk2(s[2 * 33], s[3 * 33]); o.z = pk2(s[4 * 33], s[5 * 33]); o.w = pk2(s[6 * 33], s[7 * 33]);
        *(u32x4*)(WT + (size_t)(row_off + n0 + n) * K + k0 + 8 * c) = o; }
    asm volatile("s_waitcnt lgkmcnt(0)" ::: "memory");
}
__device__ __forceinline__ void p0_prologue(const Params& P, LAS unsigned char* lds, int vcu, int G) {
    const int tid = threadIdx.x, lane = tid & 63, wave = __builtin_amdgcn_readfirstlane(tid >> 6);
    unsigned char* ws = P.ws;
    LAS float* scr = (LAS float*)(lds + wave * 16384);
    const int gw = vcu * NWAVES + wave, NGW = G * NWAVES;
    constexpr int I_QKV = (DM / 64) * (3 * DM / 32), I_O = (DM / 64) * (DM / 32), I_UP = (DM / 64) * (FF / 32), I_DN = (FF / 64) * (DM / 32), I_IN = (DM / 64) * (DSA_IN_PAD / 32), I_QI = (DQ / 64) * (512 / 32);
    constexpr int NITEMS = I_QKV + I_O + 2 * I_UP + 2 * I_DN + I_IN + I_QI;
    for (int it = gw; it < NITEMS; it += NGW) {
        int r = it;
        if (r < I_QKV) { p0_transpose_item(P.moba_w_qkv, P.ln_attn, DM, 3 * DM, 3 * DM, (bf16_t*)(ws + WS_WQKV0), 0, scr, r, lane); continue; } r -= I_QKV;
        if (r < I_O) { p0_transpose_item(P.moba_w_o, nullptr, DM, DM, DM, (bf16_t*)(ws + WS_WO0), 0, scr, r, lane); continue; } r -= I_O;
        if (r < I_UP) { p0_transpose_item(P.mlp_w_up, P.ln_mlp, DM, FF, FF, (bf16_t*)(ws + WS_WUP0), 0, scr, r, lane); continue; } r -= I_UP;
        if (r < I_UP) { p0_transpose_item(P.mlp_w_up + (size_t)DM * FF, P.ln_mlp + DM, DM, FF, FF, (bf16_t*)(ws + WS_WUP1), 0, scr, r, lane); continue; } r -= I_UP;
        if (r < I_DN) { p0_transpose_item(P.mlp_w_down, nullptr, FF, DM, DM, (bf16_t*)(ws + WS_WDN0), 0, scr, r, lane); continue; } r -= I_DN;
        if (r < I_DN) { p0_transpose_item(P.mlp_w_down + (size_t)FF * DM, nullptr, FF, DM, DM, (bf16_t*)(ws + WS_WDN1), 0, scr, r, lane); continue; } r -= I_DN;
        if (r < I_IN) { p0_transpose_item(P.dsa_w_in, P.ln_attn + DM, DM, DSA_IN, DSA_IN_PAD, (bf16_t*)(ws + WS_WIN1), 0, scr, r, lane); continue; } r -= I_IN;
        p0_transpose_item(P.dsa_w_qi, P.dsa_g_q, DQ, 512, 512, (bf16_t*)(ws + WS_WQ1), 4096, scr, r, lane);
    }
    const int gt = vcu * NTHR + tid, NGT = G * NTHR;
    for (int it = gt; it < NH * DC * (DQ / 8); it += NGT) {
        const int c = it & 255, h = (it >> 8) & 15, k8 = (it >> 12) * 8;
        float a[8];
#pragma unroll
        for (int i = 0; i < 8; ++i) a[i] = 0.f;
        const float* uk = P.dsa_w_uk + (size_t)h * HD * DC + c; const float* uq = P.dsa_w_uq + (size_t)k8 * DM + h * HD;
        for (int d = 0; d < HD; ++d) { const float w = uk[(size_t)d * DC];
#pragma unroll
            for (int i = 0; i < 8; ++i) a[i] += uq[(size_t)i * DM + d] * w; }
#pragma unroll
        for (int i = 0; i < 8; ++i) a[i] *= C2 * P.dsa_g_q[k8 + i];
        u32x4 o; o.x = pk2(a[0], a[1]); o.y = pk2(a[2], a[3]); o.z = pk2(a[4], a[5]); o.w = pk2(a[6], a[7]);
        *(u32x4*)((bf16_t*)(ws + WS_WQ1) + (size_t)(h * DC + c) * DQ + k8) = o;
    }
    for (int it = gt; it < DM * (NH * DC / 8); it += NGT) {
        const int n = it & 1023, kk8 = (it >> 10) * 8, h = kk8 >> 8, c8 = kk8 & 255;
        float a[8];
#pragma unroll
        for (int i = 0; i < 8; ++i) a[i] = 0.f;
        const float* uv = P.dsa_w_uv + ((size_t)h * DC + c8) * HD; const float* wo = P.dsa_w_o + (size_t)h * HD * DM + n;
        for (int d = 0; d < HD; ++d) { const float w = wo[(size_t)d * DM];
#pragma unroll
            for (int i = 0; i < 8; ++i) a[i] += uv[i * HD + d] * w; }
        u32x4 o; o.x = pk2(a[0], a[1]); o.y = pk2(a[2], a[3]); o.z = pk2(a[4], a[5]); o.w = pk2(a[6], a[7]);
        *(u32x4*)((bf16_t*)(ws + WS_WOV1) + (size_t)n * (NH * DC) + kk8) = o;
    }
    for (int it = gt; it < 128 * NH; it += NGT) { const int d = it >> 4, h = it & 15; ((float*)(ws + WS_LUT))[it] = P.rel_bias[BUCKET_TAB[d] * NH + h] * LOG2E; }
    for (int m = gw; m < T; m += NGW) {
        const f32x4* xr = (const f32x4*)(P.x + (size_t)m * DM) + lane; float s = 0.f;
        unsigned long long* o8 = (unsigned long long*)((bf16_t*)(ws + WS_XB) + (size_t)m * DM) + lane;
#pragma unroll
        for (int j = 0; j < 4; ++j) { const f32x4 v = xr[64 * j]; s += sumsq4(v); o8[64 * j] = (unsigned long long)pk2(v[0], v[1]) | ((unsigned long long)pk2(v[2], v[3]) << 32); }
        s = wave_sum(s);
        if (lane < 16) ((float*)(ws + WS_SSP))[(size_t)m * 16 + lane] = (lane == 0) ? s : 0.f;
    }
}

__device__ __forceinline__ void ckv_norm(const Params& P, int vcu, int G) {
    const int tid = threadIdx.x, lane = tid & 63, wave = __builtin_amdgcn_readfirstlane(tid >> 6);
    const int gw = vcu * NWAVES + wave, NGW = G * NWAVES; unsigned char* ws = P.ws;
    const f32x4 g = ((const f32x4*)P.dsa_g_kv)[lane];
    for (int m = gw; m < T; m += NGW) {
        const f32x4 p = *(const f32x4*)((const float*)(ws + WS_SSQ) + (size_t)m * 8 + 4);
        const float rs = 1.0f / sqrtf(((p[0] + p[1]) + (p[2] + p[3])) * (1.0f / 256.0f) + EPS);
        const f32x4 v = ((const f32x4*)((const float*)(ws + WS_CKV) + (size_t)m * DC))[lane] * rs * g;
        ((unsigned long long*)((bf16_t*)(ws + WS_CKVN) + (size_t)m * DC))[lane] = (unsigned long long)pk2(v[0], v[1]) | ((unsigned long long)pk2(v[2], v[3]) << 32);
    }
}
__device__ __forceinline__ void final_norm(const Params& P, int vcu, int G) {
    const int tid = threadIdx.x, lane = tid & 63, wave = __builtin_amdgcn_readfirstlane(tid >> 6);
    const int gw = vcu * NWAVES + wave, NGW = G * NWAVES; unsigned char* ws = P.ws;
    f32x4 g[4];
#pragma unroll
    for (int j = 0; j < 4; ++j) g[j] = ((const f32x4*)P.final_norm)[lane + 64 * j];
    for (int m = gw; m < T; m += NGW) {
        const float rs = pg8::row_rstd16((const float*)(ws + WS_SSP), m);
        f32x4* xr = (f32x4*)(P.out + (size_t)m * DM) + lane;
#pragma unroll
        for (int j = 0; j < 4; ++j) xr[64 * j] = xr[64 * j] * rs * g[j];
    }
}

__global__ void __launch_bounds__(256) naive_moba(Params P) {
    __shared__ float plog[4][1024];
    unsigned char* ws = P.ws;
    const int lane = threadIdx.x & 63, w = threadIdx.x >> 6;
    const int gid = blockIdx.x * 4 + w;
    const int tok = gid >> 4, h = gid & 15, b = tok / SEQ, tl = tok % SEQ, j = tl / MBLK;
    const bf16_t* Q = (const bf16_t*)(ws + WS_BIG); const bf16_t* K = Q + (size_t)T * DM; const bf16_t* V = K + (size_t)T * DM;
    const float* ksum = (const float*)(ws + WS_KSUM); const float* lut = (const float*)(ws + WS_LUT);
    float q[64];
    { const u32x4* qp = (const u32x4*)(Q + (size_t)tok * DM + h * HD);
#pragma unroll
      for (int i = 0; i < 8; ++i) { const u32x4 v = qp[i]; q[8*i] = bflo(v.x); q[8*i+1] = bfhi(v.x); q[8*i+2] = bflo(v.y); q[8*i+3] = bfhi(v.y); q[8*i+4] = bflo(v.z); q[8*i+5] = bfhi(v.z); q[8*i+6] = bflo(v.w); q[8*i+7] = bfhi(v.w); } }
    float gate = -3.0e38f;
    if (lane < j) { const float* k0 = ksum + ((size_t)((b * NBLK + lane) * 2)) * DM + h * HD; const float* k1 = k0 + DM; float s = 0.f;
#pragma unroll
        for (int d = 0; d < 64; ++d) s += q[d] * (k0[d] + k1[d]); gate = s; }
    int rank = 0;
    for (int m2 = 0; m2 < NBLK; ++m2) { const float gm = __shfl(gate, m2); if (m2 < j && (gm > gate || (gm == gate && m2 < lane))) ++rank; }
    const unsigned long long selmask = __ballot(lane < j && rank < 3);
    int blks[4]; int nb = 1; blks[0] = j;
    for (int n = 0; n < NBLK; ++n) if ((selmask >> n) & 1ull) { blks[nb < 4 ? nb : 3] = n; ++nb; }
    if (nb > 4) nb = 4;
    float mx = -3.0e38f;
    for (int s = 0; s < nb; ++s) { const int blk = blks[s];
        for (int i = 0; i < 4; ++i) { const int kl = blk * MBLK + lane + 64 * i; const int dist = tl - kl; float lg = -3.0e38f;
            if (dist >= 0) { const u32x4* kp = (const u32x4*)(K + (size_t)(b * SEQ + kl) * DM + h * HD); float a = 0.f;
#pragma unroll
                for (int c = 0; c < 8; ++c) { const u32x4 v = kp[c]; a += q[8*c] * bflo(v.x) + q[8*c+1] * bfhi(v.x) + q[8*c+2] * bflo(v.y) + q[8*c+3] * bfhi(v.y) + q[8*c+4] * bflo(v.z) + q[8*c+5] * bfhi(v.z) + q[8*c+6] * bflo(v.w) + q[8*c+7] * bfhi(v.w); }
                lg = a + lut[(dist < 127 ? dist : 127) * NH + h]; }
            plog[w][s * 256 + lane + 64 * i] = lg; mx = fmaxf(mx, lg); } }
    mx = wave_max(mx);
    float sum = 0.f;
    for (int s = 0; s < nb; ++s) for (int i = 0; i < 4; ++i) { const int idx = s * 256 + lane + 64 * i; const float lg = plog[w][idx]; const float p = (lg > -1.0e38f) ? exp2f(lg - mx) : 0.f; plog[w][idx] = p; sum += p; }
    sum = wave_sum(sum);
    __syncthreads();
    float o = 0.f;
    for (int s = 0; s < nb; ++s) { const int blk = blks[s]; const int nk = (blk == j) ? (tl - j * MBLK + 1) : MBLK;
        const bf16_t* vp = V + (size_t)(b * SEQ + blk * MBLK) * DM + h * HD + lane;
        for (int kk = 0; kk < nk; ++kk) o += plog[w][s * 256 + kk] * bf2f(vp[(size_t)kk * DM]); }
    bf16_t* O = (bf16_t*)(ws + WS_BIG);
    O[(size_t)tok * DM + h * HD + lane] = (bf16_t)f2bf(o / sum);
}

__global__ void __launch_bounds__(256) naive_indexer(Params P) {
    __shared__ float qs[512]; __shared__ unsigned keys[SEQ]; __shared__ unsigned cnt; __shared__ unsigned wcnt[4];
    unsigned char* ws = P.ws;
    const int tid = threadIdx.x, lane = tid & 63, w = tid >> 6;
    const int tok = blockIdx.x, b = tok / SEQ, tl = tok % SEQ;
    const bf16_t* QIDX = (const bf16_t*)(ws + WS_QIDX); const bf16_t* KIDX = (const bf16_t*)(ws + WS_KIDX); const float* WIDX = (const float*)(ws + WS_WIDX);
    unsigned* MASK = (unsigned*)(ws + WS_MASK) + (size_t)tok * 128;
    for (int i = tid; i < 512; i += 256) qs[i] = bf2f(QIDX[(size_t)tok * 512 + i]);
    float wv[8];
#pragma unroll
    for (int i = 0; i < 8; ++i) wv[i] = WIDX[(size_t)tok * 8 + i];
    __syncthreads();
    const int nvalid = tl + 1;
    for (int s = tid; s < SEQ; s += 256) {
        unsigned key = 0u;
        if (s < nvalid) {
            const u32x4* kp = (const u32x4*)(KIDX + (size_t)(b * SEQ + s) * ID); float kf[64];
#pragma unroll
            for (int c = 0; c < 8; ++c) { const u32x4 v = kp[c]; kf[8*c] = bflo(v.x); kf[8*c+1] = bfhi(v.x); kf[8*c+2] = bflo(v.y); kf[8*c+3] = bfhi(v.y); kf[8*c+4] = bflo(v.z); kf[8*c+5] = bfhi(v.z); kf[8*c+6] = bflo(v.w); kf[8*c+7] = bfhi(v.w); }
            float sc = 0.f;
#pragma unroll
            for (int hh = 0; hh < 8; ++hh) { float a = 0.f;
#pragma unroll
                for (int d = 0; d < 64; ++d) a += qs[hh * 64 + d] * kf[d];
                sc += wv[hh] * fmaxf(a, 0.f); }
            const unsigned u = __builtin_bit_cast(unsigned, sc); key = (u & 0x80000000u) ? ~u : (u | 0x80000000u);
            if (key == 0u) key = 1u;
        }
        keys[s] = key;
    }
    __syncthreads();
    unsigned thr = 0u; int need_eq = 0;
    if (nvalid <= TOPK) { thr = 0u; need_eq = 0; }
    else {
        unsigned tau = 0u;
        for (int bit = 31; bit >= 0; --bit) { const unsigned cand = tau | (1u << bit);
            if (tid == 0) cnt = 0u; __syncthreads();
            unsigned c = 0; for (int s = tid; s < SEQ; s += 256) c += (keys[s] >= cand) ? 1u : 0u;
            c = (unsigned)wave_sum((float)c); if (lane == 0) atomicAdd(&cnt, c); __syncthreads();
            if (cnt >= (unsigned)TOPK) tau = cand; __syncthreads(); }
        if (tid == 0) cnt = 0u; __syncthreads();
        unsigned c = 0; for (int s = tid; s < SEQ; s += 256) c += (keys[s] > tau) ? 1u : 0u;
        c = (unsigned)wave_sum((float)c); if (lane == 0) atomicAdd(&cnt, c); __syncthreads();
        thr = tau; need_eq = TOPK - (int)cnt; __syncthreads();
    }
    int eq_before = 0;
    for (int base = 0; base < SEQ; base += 256) { const int s = base + tid; const unsigned key = keys[s];
        const bool eq = (need_eq > 0) && (key == thr) && key != 0u; const unsigned long long bm = __ballot(eq);
        if (lane == 0) wcnt[w] = (unsigned)__popcll(bm); __syncthreads();
        int pre = eq_before; for (int ww = 0; ww < w; ++ww) pre += (int)wcnt[ww];
        pre += __popcll(bm & ((1ull << lane) - 1ull));
        const bool sel = (key > thr) || (eq && pre < need_eq);
        const unsigned long long sm = __ballot(sel);
        if (lane == 0) { MASK[(s >> 5)] = (unsigned)sm; MASK[(s >> 5) + 1] = (unsigned)(sm >> 32); }
        eq_before += (int)(wcnt[0] + wcnt[1] + wcnt[2] + wcnt[3]); __syncthreads(); }
}

__global__ void __launch_bounds__(256) naive_dsa_attn(Params P) {
    __shared__ float ql[NH * DC]; __shared__ float lg[NH][TOPK]; __shared__ int idx[TOPK]; __shared__ int wpre[128];
    unsigned char* ws = P.ws;
    const int tid = threadIdx.x, lane = tid & 63, w = tid >> 6;
    const int tok = blockIdx.x, b = tok / SEQ, tl = tok % SEQ;
    bf16_t* QLAT = (bf16_t*)(ws + WS_BIG) + (size_t)tok * (NH * DC);
    const bf16_t* CK = (const bf16_t*)(ws + WS_CKVN) + (size_t)b * SEQ * DC; const float* lut = (const float*)(ws + WS_LUT);
    const unsigned* MASK = (const unsigned*)(ws + WS_MASK) + (size_t)tok * 128;
    for (int i = tid; i < NH * DC; i += 256) ql[i] = bf2f(QLAT[i]);
    if (tid < 128) wpre[tid] = __popc(MASK[tid]);
    __syncthreads();
    if (tid == 0) { int a = 0; for (int i = 0; i < 128; ++i) { const int c = wpre[i]; wpre[i] = a; a += c; } }
    __syncthreads();
    const int nsel = (tl + 1 < TOPK) ? tl + 1 : TOPK;
    if (tid < 128) { unsigned m = MASK[tid]; int p = wpre[tid]; while (m) { const int bit = __ffs(m) - 1; m &= m - 1; if (p < TOPK) idx[p] = tid * 32 + bit; ++p; } }
    __syncthreads();
    if (tid < nsel) { const int key = idx[tid]; const u32x4* cp = (const u32x4*)(CK + (size_t)key * DC); float a[NH];
#pragma unroll
        for (int hh = 0; hh < NH; ++hh) a[hh] = 0.f;
        for (int c = 0; c < DC / 8; ++c) { const u32x4 v = cp[c]; const float f0 = bflo(v.x), f1 = bfhi(v.x), f2 = bflo(v.y), f3 = bfhi(v.y), f4 = bflo(v.z), f5 = bfhi(v.z), f6 = bflo(v.w), f7 = bfhi(v.w);
#pragma unroll
            for (int hh = 0; hh < NH; ++hh) { const float* qq = ql + hh * DC + c * 8; a[hh] += qq[0] * f0 + qq[1] * f1 + qq[2] * f2 + qq[3] * f3 + qq[4] * f4 + qq[5] * f5 + qq[6] * f6 + qq[7] * f7; } }
        const int dist = tl - key; const float* bl = lut + (dist < 127 ? dist : 127) * NH;
#pragma unroll
        for (int hh = 0; hh < NH; ++hh) lg[hh][tid] = a[hh] + bl[hh]; }
    __syncthreads();
    for (int hh = w * 4; hh < w * 4 + 4; ++hh) { float v[4]; float mx = -3.0e38f;
#pragma unroll
        for (int i = 0; i < 4; ++i) { const int k = lane + 64 * i; v[i] = (k < nsel) ? lg[hh][k] : -3.0e38f; mx = fmaxf(mx, v[i]); }
        mx = wave_max(mx); float sum = 0.f;
#pragma unroll
        for (int i = 0; i < 4; ++i) { const int k = lane + 64 * i; v[i] = (k < nsel) ? exp2f(v[i] - mx) : 0.f; sum += v[i]; }
        sum = wave_sum(sum); const float inv = 1.0f / sum;
#pragma unroll
        for (int i = 0; i < 4; ++i) lg[hh][lane + 64 * i] = v[i] * inv; }
    __syncthreads();
    float o[NH];
#pragma unroll
    for (int hh = 0; hh < NH; ++hh) o[hh] = 0.f;
    for (int k = 0; k < nsel; ++k) { const float v = bf2f(CK[(size_t)idx[k] * DC + tid]);
#pragma unroll
        for (int hh = 0; hh < NH; ++hh) o[hh] += lg[hh][k] * v; }
#pragma unroll
    for (int hh = 0; hh < NH; ++hh) QLAT[hh * DC + tid] = (bf16_t)f2bf(o[hh]);
}

__device__ __forceinline__ int vcu_of(int bx, int G) { return (G % 8 == 0) ? (bx % 8) * (G / 8) + bx / 8 : bx; }

__global__ void __launch_bounds__(NTHR, 2) k_prologue(Params P) {
    extern __shared__ __attribute__((aligned(16))) unsigned char lds[];
    p0_prologue(P, (LAS unsigned char*)lds, vcu_of(blockIdx.x, gridDim.x), gridDim.x);
}
__global__ void __launch_bounds__(NTHR, 2) k_ckvnorm(Params P) { ckv_norm(P, vcu_of(blockIdx.x, gridDim.x), gridDim.x); }
__global__ void __launch_bounds__(NTHR, 2) k_final(Params P) { final_norm(P, vcu_of(blockIdx.x, gridDim.x), gridDim.x); }

template <int PH> __global__ void __launch_bounds__(NTHR, 2) k_gemm(Params P) {
    extern __shared__ __attribute__((aligned(16))) unsigned char lds[];
    unsigned char* ws = P.ws; LAS unsigned char* L = (LAS unsigned char*)lds; const int G = gridDim.x, bx = blockIdx.x;
    bf16_t* XB = (bf16_t*)(ws + WS_XB); float* SSP = (float*)(ws + WS_SSP); bf16_t* BIG = (bf16_t*)(ws + WS_BIG);
    pg8::StaticOrder S;
    if constexpr (PH == 1) {
        pg8::Gemm g{XB, (const bf16_t*)(ws + WS_WQKV0), T, 3 * DM, DM}; S.init(T, 3 * DM, G, bx);
        pg8::EpiQKV E{BIG, SSP, (float*)(ws + WS_KSUM)}; pg8::gemm_phase<pg8::EpiQKV, pg8::StaticOrder, true, true>(L, g, S, E);
    } else if constexpr (PH == 3) {
        pg8::Gemm g{BIG, (const bf16_t*)(ws + WS_WO0), T, DM, DM}; S.init(T, DM, G, bx);
        pg8::EpiRes E{P.x, P.out, XB, SSP}; pg8::gemm_phase<pg8::EpiRes, pg8::StaticOrder, true, true>(L, g, S, E);
    } else if constexpr (PH == 4 || PH == 11) {
        pg8::Gemm g{XB, (const bf16_t*)(ws + (PH == 4 ? WS_WUP0 : WS_WUP1)), T, FF, DM}; S.init(T, FF, G, bx);
        pg8::EpiUp E{BIG, SSP}; pg8::gemm_phase<pg8::EpiUp, pg8::StaticOrder, true, true>(L, g, S, E);
    } else if constexpr (PH == 5 || PH == 12) {
        pg8::Gemm g{BIG, (const bf16_t*)(ws + (PH == 5 ? WS_WDN0 : WS_WDN1)), T, DM, FF}; S.init(T, DM, G, bx);
        pg8::EpiRes E{P.out, P.out, XB, SSP}; pg8::gemm_phase<pg8::EpiRes, pg8::StaticOrder, true, true>(L, g, S, E);
    } else if constexpr (PH == 6) {
        pg8::Gemm g{XB, (const bf16_t*)(ws + WS_WIN1), T, DSA_IN_PAD, DM}; S.init(T, DSA_IN_PAD, G, bx);
        pg8::EpiDsaIn E{(bf16_t*)(ws + WS_CQ), (float*)(ws + WS_CKV), (bf16_t*)(ws + WS_KIDX), (float*)(ws + WS_WIDX), (float*)(ws + WS_SSQ), SSP};
        pg8::gemm_phase<pg8::EpiDsaIn, pg8::StaticOrder, true, true>(L, g, S, E);
    } else if constexpr (PH == 7) {
        pg8::Gemm g{(const bf16_t*)(ws + WS_CQ), (const bf16_t*)(ws + WS_WQ1), T, 4608, DQ}; S.init(T, 4608, G, bx);
        pg8::EpiDsaQ E{BIG, (bf16_t*)(ws + WS_QIDX), (const float*)(ws + WS_SSQ)}; pg8::gemm_phase<pg8::EpiDsaQ, pg8::StaticOrder, true, true>(L, g, S, E);
    } else if constexpr (PH == 10) {
        pg8::Gemm g{BIG, (const bf16_t*)(ws + WS_WOV1), T, DM, NH * DC}; S.init(T, DM, G, bx);
        pg8::EpiRes E{P.out, P.out, XB, SSP}; pg8::gemm_phase<pg8::EpiRes, pg8::StaticOrder, true, true>(L, g, S, E);
    }
}

extern "C" void kernel_launch(void* const* d_in, const int* in_sizes, int n_in, void* d_out, int out_size, void* d_ws, size_t ws_size, hipStream_t stream) {
    static int grid = 0;
    if (grid == 0) {
        if (n_in != 17 || in_sizes[0] != T * DM || out_size != T * DM || ws_size < WS_END) { fprintf(stderr, "kernel_launch: unexpected shapes (n_in %d, in0 %d, out %d, ws %zu)\n", n_in, n_in > 0 ? in_sizes[0] : -1, out_size, ws_size); grid = -1; return; }
        int dev = 0, cus = 0;
        if (hipGetDevice(&dev) != hipSuccess || hipDeviceGetAttribute(&cus, hipDeviceAttributeMultiprocessorCount, dev) != hipSuccess) { grid = -1; return; }
        bool ok = true;
        ok &= hipFuncSetAttribute((const void*)k_prologue, hipFuncAttributeMaxDynamicSharedMemorySize, LDS_BYTES) == hipSuccess;
        ok &= hipFuncSetAttribute((const void*)k_gemm<1>, hipFuncAttributeMaxDynamicSharedMemorySize, LDS_BYTES) == hipSuccess;
        ok &= hipFuncSetAttribute((const void*)k_gemm<3>, hipFuncAttributeMaxDynamicSharedMemorySize, LDS_BYTES) == hipSuccess;
        ok &= hipFuncSetAttribute((const void*)k_gemm<4>, hipFuncAttributeMaxDynamicSharedMemorySize, LDS_BYTES) == hipSuccess;
        ok &= hipFuncSetAttribute((const void*)k_gemm<5>, hipFuncAttributeMaxDynamicSharedMemorySize, LDS_BYTES) == hipSuccess;
        ok &= hipFuncSetAttribute((const void*)k_gemm<6>, hipFuncAttributeMaxDynamicSharedMemorySize, LDS_BYTES) == hipSuccess;
        ok &= hipFuncSetAttribute((const void*)k_gemm<7>, hipFuncAttributeMaxDynamicSharedMemorySize, LDS_BYTES) == hipSuccess;
        ok &= hipFuncSetAttribute((const void*)k_gemm<10>, hipFuncAttributeMaxDynamicSharedMemorySize, LDS_BYTES) == hipSuccess;
        ok &= hipFuncSetAttribute((const void*)k_gemm<11>, hipFuncAttributeMaxDynamicSharedMemorySize, LDS_BYTES) == hipSuccess;
        ok &= hipFuncSetAttribute((const void*)k_gemm<12>, hipFuncAttributeMaxDynamicSharedMemorySize, LDS_BYTES) == hipSuccess;
        if (!ok) { fprintf(stderr, "kernel_launch: hipFuncSetAttribute failed\n"); grid = -1; return; }
        (void)hipGetLastError();
        grid = cus;
    }
    if (grid < 0) return;
    Params P{};
    P.x = (const float*)d_in[0]; P.rel_bias = (const float*)d_in[1]; P.ln_attn = (const float*)d_in[2]; P.ln_mlp = (const float*)d_in[3]; P.moba_w_qkv = (const float*)d_in[4]; P.moba_w_o = (const float*)d_in[5];
    P.dsa_w_in = (const float*)d_in[6]; P.dsa_g_q = (const float*)d_in[7]; P.dsa_g_kv = (const float*)d_in[8]; P.dsa_w_uq = (const float*)d_in[9]; P.dsa_w_qi = (const float*)d_in[10]; P.dsa_w_uk = (const float*)d_in[11];
    P.dsa_w_uv = (const float*)d_in[12]; P.dsa_w_o = (const float*)d_in[13]; P.mlp_w_up = (const float*)d_in[14]; P.mlp_w_down = (const float*)d_in[15]; P.final_norm = (const float*)d_in[16];
    P.out = (float*)d_out; P.ws = (unsigned char*)d_ws;
    const dim3 g(grid), b(NTHR);
    hipLaunchKernelGGL(k_prologue, g, b, LDS_BYTES, stream, P);
    hipLaunchKernelGGL(k_gemm<1>, g, b, LDS_BYTES, stream, P);
    hipLaunchKernelGGL(naive_moba, dim3(T * NH / 4), dim3(256), 0, stream, P);
    hipLaunchKernelGGL(k_gemm<3>, g, b, LDS_BYTES, stream, P);
    hipLaunchKernelGGL(k_gemm<4>, g, b, LDS_BYTES, stream, P);
    hipLaunchKernelGGL(k_gemm<5>, g, b, LDS_BYTES, stream, P);
    hipLaunchKernelGGL(k_gemm<6>, g, b, LDS_BYTES, stream, P);
    hipLaunchKernelGGL(k_ckvnorm, g, b, 0, stream, P);
    hipLaunchKernelGGL(k_gemm<7>, g, b, LDS_BYTES, stream, P);
    hipLaunchKernelGGL(naive_indexer, dim3(T), dim3(256), 0, stream, P);
    hipLaunchKernelGGL(naive_dsa_attn, dim3(T), dim3(256), 0, stream, P);
    hipLaunchKernelGGL(k_gemm<10>, g, b, LDS_BYTES, stream, P);
    hipLaunchKernelGGL(k_gemm<11>, g, b, LDS_BYTES, stream, P);
    hipLaunchKernelGGL(k_gemm<12>, g, b, LDS_BYTES, stream, P);
    hipLaunchKernelGGL(k_final, g, b, 0, stream, P);
}
```

```cpp
#include <hip/hip_runtime.h>
#include <cstdio>
#include <cstdint>
#ifndef REP_PRO
#define REP_PRO 1
#endif
#ifndef REP_QKV
#define REP_QKV 1
#endif
#ifndef REP_MOBA
#define REP_MOBA 1
#endif
#ifndef REP_UP0
#define REP_UP0 1
#endif
#ifndef REP_IDX
#define REP_IDX 1
#endif

constexpr int NB = 8, SEQ = 4096, DM = 1024, NH = 16, HD = 64, FF = 4096;
constexpr int T = NB * SEQ;
constexpr int MBLK = 256, NBLK = SEQ / MBLK;
constexpr int DQ = 256, DC = 256, IH = 8, ID = 64;
constexpr int DSA_IN = DQ + DC + ID + IH;
constexpr int DSA_IN_PAD = 768;
constexpr int TOPK = 256;
constexpr float EPS = 1e-6f;
constexpr float LOG2E = 1.4426950408889634f;
constexpr float C2 = 0.125f * LOG2E;

constexpr size_t MiB = 1u << 20;
constexpr size_t WS_CTL = 0, CTL_ZERO_BYTES = 1 * MiB;
constexpr size_t WS_WQKV0 = 1 * MiB, WS_WO0 = 7 * MiB, WS_WUP0 = 9 * MiB, WS_WDN0 = 17 * MiB, WS_WIN1 = 25 * MiB, WS_WQ1 = 27 * MiB,
                 WS_WUVB = 30 * MiB, WS_WO1 = 32 * MiB, WS_WUP1 = 38 * MiB, WS_WDN1 = 46 * MiB;
constexpr size_t WS_SSP = 54 * MiB;
constexpr size_t WS_KSUM = 56 * MiB;
constexpr size_t WS_LUT = 57 * MiB;
constexpr size_t WS_XB = 58 * MiB;
constexpr size_t WS_CQ = 122 * MiB;
constexpr size_t WS_CKVN = 138 * MiB;
constexpr size_t WS_CKV8 = 138 * MiB;
constexpr size_t WS_CQ8 = 146 * MiB;
constexpr size_t WS_WQI = 28 * MiB;
constexpr size_t WS_KIDX = 154 * MiB;
constexpr size_t WS_WIDX = 158 * MiB;
constexpr size_t WS_SSQ = 159 * MiB;
constexpr size_t WS_O0 = 160 * MiB;
constexpr size_t WS_QIDX = 160 * MiB;
constexpr size_t WS_MASK = 192 * MiB;
constexpr size_t WS_CKV = 208 * MiB;
constexpr size_t WS_BIG = 240 * MiB;
constexpr size_t WS_END = 496 * MiB;

typedef unsigned short bf16_t;
typedef float f32x4 __attribute__((ext_vector_type(4)));
typedef float f32x2 __attribute__((ext_vector_type(2)));
typedef unsigned u32x4 __attribute__((ext_vector_type(4)));
typedef unsigned u32x2 __attribute__((ext_vector_type(2)));
typedef short bf16x8 __attribute__((ext_vector_type(8)));
#define GAS __attribute__((address_space(1)))
#define LAS __attribute__((address_space(3)))

__device__ __forceinline__ unsigned f2bf(float f) { unsigned u = __builtin_bit_cast(unsigned, f); return (u + 0x7fffu + ((u >> 16) & 1u)) >> 16; }
__device__ __forceinline__ unsigned pk2(float lo, float hi) { return f2bf(lo) | (f2bf(hi) << 16); }
__device__ __forceinline__ float bf2f(unsigned h) { return __builtin_bit_cast(float, h << 16); }
__device__ __forceinline__ float bflo(unsigned w) { return __builtin_bit_cast(float, w << 16); }
__device__ __forceinline__ float bfhi(unsigned w) { return __builtin_bit_cast(float, w & 0xffff0000u); }

__device__ const unsigned char BUCKET_TAB[128] = {0,1,2,3,4,5,6,7,8,9,10,11,12,13,14,15,16,16,16,17,17,18,18,18,19,19,19,20,20,20,20,21,21,21,21,22,22,22,22,22,23,23,23,23,23,23,24,24,24,24,24,24,25,25,25,25,25,25,25,26,26,26,26,26,26,26,26,27,27,27,27,27,27,27,27,27,27,28,28,28,28,28,28,28,28,28,28,29,29,29,29,29,29,29,29,29,29,29,29,30,30,30,30,30,30,30,30,30,30,30,30,30,30,31,31,31,31,31,31,31,31,31,31,31,31,31,31,31};

__device__ __forceinline__ float sumsq4(const f32x4 a) { return (a[0] * a[0] + a[1] * a[1]) + (a[2] * a[2] + a[3] * a[3]); }

namespace pg8 {
#define PG8_LAS __attribute__((address_space(3)))
typedef unsigned short bf16_t;
typedef short bf16x8 __attribute__((ext_vector_type(8)));
typedef float f32x4 __attribute__((ext_vector_type(4)));
typedef unsigned u32x4 __attribute__((ext_vector_type(4)));
constexpr int BM = 256, BK = 64, HALF = 128, HTB = HALF * BK * 2  , STAGE_BYTES = 8 * HTB, NXCD = 8, WGM = 8;

__host__ __device__ __forceinline__ int lds_byte(int r, int c) { const int st = (r >> 4) * 2 + (c >> 5), rr = r & 15, cc = c & 31, ob = rr * 64 + cc * 2; return st * 1024 + (ob ^ (((ob >> 9) & 1) << 5)); }
__host__ __device__ __forceinline__ void stage_rc(int b, int& R, int& C) { const int st = b / 1024, sb = b % 1024, swz = sb ^ (((sb >> 9) & 1) << 5); R = (st >> 1) * 16 + swz / 64; C = (st & 1) * 32 + (swz % 64) / 2; }
__host__ __device__ __forceinline__ int perm32(int rho) { const int n = rho >> 4, i = rho & 15; return 8 * (i >> 2) + 4 * n + (i & 3); }

struct Unit { int pm, pn; };
struct Gemm { const bf16_t* A; const bf16_t* Bt; int M, N, K; int lda = 0, a_pn_off = 0; };

struct StaticOrder {
    int nM, nN, nwg, G, c;
    __host__ __device__ void init(int M, int N, int G_, int c_) { nM = M / BM; nN = N / BM; nwg = nM * nN; G = G_; c = c_; }
    __host__ __device__ bool next(int i, Unit& u) const {
        const long L = (long)i * G + c; if (L >= nwg) return false;
        int wgid = (int)L; { const int q = nwg / NXCD, r = nwg % NXCD, xcd = wgid % NXCD, off = wgid / NXCD; wgid = (xcd < r ? xcd * (q + 1) : r * (q + 1) + (xcd - r) * q) + off; }
        const int nig = WGM * nN, gid = wgid / nig, fm = gid * WGM, gsz = (nM - fm) < WGM ? (nM - fm) : WGM;
        u.pm = fm + ((wgid % nig) % gsz); u.pn = (wgid % nig) / gsz; return true;
    }
    __device__ __forceinline__ void a_ready(const Unit&) const {}
    __device__ __forceinline__ void done(const Unit&) const {}
};


__device__ __forceinline__ unsigned cvt_pk_bf16(float lo, float hi) { unsigned r; asm volatile("v_cvt_pk_bf16_f32 %0, %1, %2" : "=v"(r) : "v"(lo), "v"(hi)); return r; }
__device__ __forceinline__ u32x4 pack8(const f32x4 a, const f32x4 b) { u32x4 w; w.x = cvt_pk_bf16(a[0], a[1]); w.y = cvt_pk_bf16(a[2], a[3]); w.z = cvt_pk_bf16(b[0], b[1]); w.w = cvt_pk_bf16(b[2], b[3]); return w; }
__device__ __forceinline__ u32x2 pack8_fp8(const f32x4 a, const f32x4 b) { u32x2 w; int t = __builtin_amdgcn_cvt_pk_fp8_f32(a[0], a[1], 0, false); t = __builtin_amdgcn_cvt_pk_fp8_f32(a[2], a[3], t, true); w.x = (unsigned)t;
    t = __builtin_amdgcn_cvt_pk_fp8_f32(b[0], b[1], 0, false); t = __builtin_amdgcn_cvt_pk_fp8_f32(b[2], b[3], t, true); w.y = (unsigned)t; return w; }
__device__ __forceinline__ float row_rstd16(const float* ssp, int row) {
    const f32x4* p = (const f32x4*)(ssp + (size_t)row * 16); const f32x4 a = p[0], b = p[1], c = p[2], d = p[3];
    const float s = ((a[0] + a[1]) + (a[2] + a[3])) + ((b[0] + b[1]) + (b[2] + b[3])) + ((c[0] + c[1]) + (c[2] + c[3])) + ((d[0] + d[1]) + (d[2] + d[3]));
    return 1.0f / sqrtf(s * (1.0f / 1024.0f) + EPS);
}

__device__ __forceinline__ float row_rstd16_q(const float* ssp, int row, int fq) {
    const f32x4 a = *(const f32x4*)(ssp + (size_t)row * 16 + 4 * fq); float s = (a[0] + a[1]) + (a[2] + a[3]);
    s += __shfl_xor(s, 16); s += __shfl_xor(s, 32);
    return 1.0f / sqrtf(s * (1.0f / 1024.0f) + EPS);
}

struct EpiQKV {
    static constexpr bool PERM = true, AFTER_DRAIN = false;
    bf16_t* Q; const float* ssp; float* ksum;
    __device__ __forceinline__ void operator()(const f32x4 (&acc)[2][2][4][2], const Unit& u, int wr, int wc, int fr, int fq) const {
        const int row0 = u.pm * BM + wr * 64 + fr; int colt = u.pn * BM; const int t = colt >> 10; colt &= 1023;
        unsigned char* base = (unsigned char*)Q + (size_t)t * T * DM; const float sc = (t == 0) ? C2 * 8.0f : 1.0f;
        const int col0 = colt + wc * 32 + 8 * fq;
        f32x4 cs[2][2];
#pragma unroll
        for (int bj = 0; bj < 2; ++bj)
#pragma unroll
            for (int n = 0; n < 2; ++n) cs[bj][n] = (f32x4){0.f, 0.f, 0.f, 0.f};
#pragma unroll
        for (int ai = 0; ai < 2; ++ai)
#pragma unroll
            for (int m = 0; m < 4; ++m) { const int row = row0 + ai * HALF + m * 16; const float rs = row_rstd16_q(ssp, row, fq) * sc; unsigned char* rowp = base + (size_t)row * DM + col0;
#pragma unroll
                for (int bj = 0; bj < 2; ++bj) { const f32x4 v0 = acc[ai][bj][m][0] * rs, v1 = acc[ai][bj][m][1] * rs; cs[bj][0] += v0; cs[bj][1] += v1;
                    *(u32x2*)(rowp + bj * HALF) = pack8_fp8(v0, v1); } }
        if (t == 1) {
#pragma unroll
            for (int bj = 0; bj < 2; ++bj)
#pragma unroll
                for (int n = 0; n < 2; ++n) { f32x4 s = cs[bj][n];
#pragma unroll
                    for (int o = 1; o < 16; o <<= 1) { s[0] += __shfl_xor(s[0], o); s[1] += __shfl_xor(s[1], o); s[2] += __shfl_xor(s[2], o); s[3] += __shfl_xor(s[3], o); }
                    if (fr == 0) *(f32x4*)(ksum + ((size_t)(u.pm * 2 + wr)) * DM + col0 + bj * HALF + 4 * n) = s; }
        }
    }
};
template <bool BASE32, bool OUT32> struct EpiRes {
    static constexpr bool PERM = true, AFTER_DRAIN = false;
    const float* base32; float* X; bf16_t* XB; float* ssp;
    __device__ __forceinline__ void operator()(const f32x4 (&acc)[2][2][4][2], const Unit& u, int wr, int wc, int fr, int fq) const {
        const int row0 = u.pm * BM + wr * 64 + fr; const int col0 = u.pn * BM + wc * 32 + 8 * fq;
#pragma unroll
        for (int ai = 0; ai < 2; ++ai)
#pragma unroll
            for (int m = 0; m < 4; ++m) { const int row = row0 + ai * HALF + m * 16; const size_t off = (size_t)row * DM + col0; float ss = 0.f;
#pragma unroll
                for (int bj = 0; bj < 2; ++bj) { f32x4 b0, b1;
                    if constexpr (BASE32) { b0 = *(const f32x4*)(base32 + off + bj * HALF); b1 = *(const f32x4*)(base32 + off + bj * HALF + 4); }
                    else { const u32x4 w = *(const u32x4*)(XB + off + bj * HALF); b0 = (f32x4){bflo(w.x), bfhi(w.x), bflo(w.y), bfhi(w.y)}; b1 = (f32x4){bflo(w.z), bfhi(w.z), bflo(w.w), bfhi(w.w)}; }
                    const f32x4 v0 = b0 + acc[ai][bj][m][0], v1 = b1 + acc[ai][bj][m][1];
                    if constexpr (OUT32) { *(f32x4*)(X + off + bj * HALF) = v0; *(f32x4*)(X + off + bj * HALF + 4) = v1; }
                    else *(u32x4*)(XB + off + bj * HALF) = pack8(v0, v1);
                    ss += sumsq4(v0) + sumsq4(v1); }
                ss += __shfl_xor(ss, 16); ss += __shfl_xor(ss, 32);
                if (fq == 0) ssp[(size_t)row * 16 + u.pn * 4 + wc] = ss; }
    }
};
struct EpiUp {
    static constexpr bool PERM = true, AFTER_DRAIN = false;
    bf16_t* U; const float* ssp;
    __device__ __forceinline__ void operator()(const f32x4 (&acc)[2][2][4][2], const Unit& u, int wr, int wc, int fr, int fq) const {
        const int row0 = u.pm * BM + wr * 64 + fr; const int col0 = u.pn * BM + wc * 32 + 8 * fq;
#pragma unroll
        for (int ai = 0; ai < 2; ++ai)
#pragma unroll
            for (int m = 0; m < 4; ++m) { const int row = row0 + ai * HALF + m * 16; const float rs = row_rstd16_q(ssp, row, fq); bf16_t* rowp = U + (size_t)row * FF + col0;
#pragma unroll
                for (int bj = 0; bj < 2; ++bj) { f32x4 v0 = acc[ai][bj][m][0] * rs, v1 = acc[ai][bj][m][1] * rs;
                    v0 = __builtin_elementwise_max(v0, (f32x4){0.f, 0.f, 0.f, 0.f}); v1 = __builtin_elementwise_max(v1, (f32x4){0.f, 0.f, 0.f, 0.f}); v0 = v0 * v0; v1 = v1 * v1;
                    *(u32x4*)(rowp + bj * HALF) = pack8(v0, v1); } }
    }
};
struct EpiDsaIn {
    static constexpr bool PERM = true, AFTER_DRAIN = false;
    bf16_t* CQ; float* CKV; bf16_t* KIDX; float* WIDX; float* ssq; const float* ssp; unsigned char* CQ8;
    __device__ __forceinline__ void operator()(const f32x4 (&acc)[2][2][4][2], const Unit& u, int wr, int wc, int fr, int fq) const {
        const int row0 = u.pm * BM + wr * 64 + fr; const int c0 = wc * 32 + 8 * fq;
#pragma unroll
        for (int ai = 0; ai < 2; ++ai)
#pragma unroll
            for (int m = 0; m < 4; ++m) { const int row = row0 + ai * HALF + m * 16; const float rs = row_rstd16_q(ssp, row, fq);
                f32x4 v[2][2];
#pragma unroll
                for (int bj = 0; bj < 2; ++bj) { v[bj][0] = acc[ai][bj][m][0] * rs; v[bj][1] = acc[ai][bj][m][1] * rs; }
                if (u.pn < 2) {
                    float ss = (sumsq4(v[0][0]) + sumsq4(v[0][1])) + (sumsq4(v[1][0]) + sumsq4(v[1][1]));
                    ss += __shfl_xor(ss, 16); ss += __shfl_xor(ss, 32);
                    if (fq == 0) ssq[(size_t)row * 8 + u.pn * 4 + wc] = ss;
                    if (u.pn == 0) {
#pragma unroll
                        for (int bj = 0; bj < 2; ++bj) { *(u32x4*)(CQ + (size_t)row * DQ + c0 + bj * HALF) = pack8(v[bj][0], v[bj][1]); *(u32x2*)(CQ8 + (size_t)row * DQ + c0 + bj * HALF) = pack8_fp8(v[bj][0], v[bj][1]); }
                    } else {
#pragma unroll
                        for (int bj = 0; bj < 2; ++bj) { *(f32x4*)(CKV + (size_t)row * DC + c0 + bj * HALF) = v[bj][0]; *(f32x4*)(CKV + (size_t)row * DC + c0 + bj * HALF + 4) = v[bj][1]; }
                    }
                } else {
                    if (wc < 2) *(u32x4*)(KIDX + (size_t)(row >> 5) * 2048 + (c0 >> 3) * 256 + (row & 31) * 8) = pack8(v[0][0], v[0][1]);
                    else if (wc == 2 && fq == 0) { const float ws = 0.04419417382415922f;
                        *(f32x4*)(WIDX + (size_t)row * IH) = v[0][0] * ws; *(f32x4*)(WIDX + (size_t)row * IH + 4) = v[0][1] * ws; }
                }
            }
    }
};
struct EpiDsaQ8 {
    static constexpr bool PERM = true, AFTER_DRAIN = false;
    unsigned char* QLAT8; const float* ssq;
    __device__ __forceinline__ void operator()(const f32x4 (&acc)[2][2][4][2], const Unit& u, int wr, int wc, int fr, int fq) const {
        const int row0 = u.pm * BM + wr * 64 + fr; const int col0 = u.pn * BM + wc * 32 + 8 * fq;
#pragma unroll
        for (int ai = 0; ai < 2; ++ai)
#pragma unroll
            for (int m = 0; m < 4; ++m) { const int row = row0 + ai * HALF + m * 16; const f32x4 p = *(const f32x4*)(ssq + (size_t)row * 8);
                const float rs = 1.0f / sqrtf(((p[0] + p[1]) + (p[2] + p[3])) * (1.0f / 256.0f) + EPS); unsigned char* rowp = QLAT8 + (size_t)row * (NH * DC) + col0;
#pragma unroll
                for (int bj = 0; bj < 2; ++bj) *(u32x2*)(rowp + bj * HALF) = pack8_fp8(acc[ai][bj][m][0] * rs, acc[ai][bj][m][1] * rs); }
    }
};
struct EpiDsaQidx {
    static constexpr bool PERM = true, AFTER_DRAIN = false;
    bf16_t* QIDX; const float* ssq;
    __device__ __forceinline__ void operator()(const f32x4 (&acc)[2][2][4][2], const Unit& u, int wr, int wc, int fr, int fq) const {
        const int row0 = u.pm * BM + wr * 64 + fr; const int col0 = u.pn * BM + wc * 32 + 8 * fq;
#pragma unroll
        for (int ai = 0; ai < 2; ++ai)
#pragma unroll
            for (int m = 0; m < 4; ++m) { const int row = row0 + ai * HALF + m * 16; const f32x4 p = *(const f32x4*)(ssq + (size_t)row * 8);
                const float rs = 1.0f / sqrtf(((p[0] + p[1]) + (p[2] + p[3])) * (1.0f / 256.0f) + EPS); bf16_t* rowp = QIDX + (size_t)row * 512 + col0;
#pragma unroll
                for (int bj = 0; bj < 2; ++bj) *(u32x4*)(rowp + bj * HALF) = pack8(acc[ai][bj][m][0] * rs, acc[ai][bj][m][1] * rs); }
    }
};
struct EpiPlain {
    static constexpr bool PERM = true, AFTER_DRAIN = false;
    bf16_t* O; int ldc;
    __device__ __forceinline__ void operator()(const f32x4 (&acc)[2][2][4][2], const Unit& u, int wr, int wc, int fr, int fq) const {
        const int row0 = u.pm * BM + wr * 64 + fr; const int col0 = u.pn * BM + wc * 32 + 8 * fq;
#pragma unroll
        for (int ai = 0; ai < 2; ++ai)
#pragma unroll
            for (int m = 0; m < 4; ++m) { bf16_t* rowp = O + (size_t)(row0 + ai * HALF + m * 16) * ldc + col0;
#pragma unroll
                for (int bj = 0; bj < 2; ++bj) *(u32x4*)(rowp + bj * HALF) = pack8(acc[ai][bj][m][0], acc[ai][bj][m][1]); }
    }
};

struct EpiPlain8 {
    static constexpr bool PERM = true, AFTER_DRAIN = false;
    unsigned char* O; int ldc;
    __device__ __forceinline__ void operator()(const f32x4 (&acc)[2][2][4][2], const Unit& u, int wr, int wc, int fr, int fq) const {
        const int row0 = u.pm * BM + wr * 64 + fr; const int col0 = u.pn * BM + wc * 32 + 8 * fq;
#pragma unroll
        for (int ai = 0; ai < 2; ++ai)
#pragma unroll
            for (int m = 0; m < 4; ++m) { unsigned char* rowp = O + (size_t)(row0 + ai * HALF + m * 16) * ldc + col0;
#pragma unroll
                for (int bj = 0; bj < 2; ++bj) *(u32x2*)(rowp + bj * HALF) = pack8_fp8(acc[ai][bj][m][0], acc[ai][bj][m][1]); }
    }
};

template <class Epi, class Sched, bool ALIGN_EPI = false, bool SP2 = false, bool FP8 = false>
__device__ __forceinline__ void gemm_phase(PG8_LAS unsigned char* lds, const Gemm g, const Sched& S, const Epi& E) {
    const int tid = threadIdx.x, wid = __builtin_amdgcn_readfirstlane(tid >> 6), lane = tid & 63, wr = wid >> 2, wc = wid & 3, fr = lane & 15, fq = lane >> 4;
    const int K = g.K, nt = K / BK; const int lda = g.lda ? g.lda : K;
    unsigned voffA[2], voffB[2];
#pragma unroll
    for (int i = 0; i < 2; ++i) { int R, C; stage_rc(tid * 16 + i * 8192, R, C); const int Rb = Epi::PERM ? ((R & ~31) + perm32(R & 31)) : R;
        voffA[i] = (unsigned)(R * lda + C) * 2u; voffB[i] = (unsigned)(Rb * K + C) * 2u; }
    const size_t kstep = (size_t)(BK * 2);
    const size_t hstep = (size_t)HALF * K * 2;
    const size_t tstep = 2 * hstep;
    const size_t hstepA = (size_t)HALF * lda * 2, tstepA = 2 * hstepA, pnoffA = (size_t)g.a_pn_off * 2;
    const unsigned ldsw = (unsigned)wid * 1024u;
    const int aoff = lds_byte(wr * 64 + fr, fq * 8), boff = lds_byte(wc * 32 + fr, fq * 8);
#define PG8_SA(b, h) (((b) * 2 + (h)) * HTB)
#define PG8_SB(b, h) ((4 + (b) * 2 + (h)) * HTB)
#define PG8_STAGE(bufoff, gbase, voff) do { _Pragma("unroll") for (int _i = 0; _i < 2; ++_i) \
        __builtin_amdgcn_global_load_lds((const unsigned*)((const char*)(gbase) + (voff)[_i]), (PG8_LAS unsigned*)(lds + (bufoff) + ldsw + _i * 8192), 16, 0, 0); } while (0)
#define PG8_LDA(dst, b, h) do { if constexpr (FP8) { _Pragma("unroll") for (int m = 0; m < 4; ++m) { const v4i_ _lo = *(const PG8_LAS v4i_*)(lds + PG8_SA(b, h) + aoff + m * 2048), _hi = *(const PG8_LAS v4i_*)(lds + PG8_SA(b, h) + aoff + m * 2048 + 1024); dst##8[m] = __builtin_shufflevector(_lo, _hi, 0, 1, 2, 3, 4, 5, 6, 7); } } \
        else { _Pragma("unroll") for (int m = 0; m < 4; ++m) _Pragma("unroll") for (int k = 0; k < 2; ++k) dst[m][k] = *(const PG8_LAS bf16x8*)(lds + PG8_SA(b, h) + aoff + m * 2048 + k * 1024); } } while (0)
#define PG8_LDB(dst, b, h) do { if constexpr (FP8) { _Pragma("unroll") for (int n = 0; n < 2; ++n) { const v4i_ _lo = *(const PG8_LAS v4i_*)(lds + PG8_SB(b, h) + boff + n * 2048), _hi = *(const PG8_LAS v4i_*)(lds + PG8_SB(b, h) + boff + n * 2048 + 1024); dst##8[n] = __builtin_shufflevector(_lo, _hi, 0, 1, 2, 3, 4, 5, 6, 7); } } \
        else { _Pragma("unroll") for (int n = 0; n < 2; ++n) _Pragma("unroll") for (int k = 0; k < 2; ++k) dst[n][k] = *(const PG8_LAS bf16x8*)(lds + PG8_SB(b, h) + boff + n * 2048 + k * 1024); } } while (0)
#define PG8_MMA(ai, bj, At, Bt) do { __builtin_amdgcn_s_setprio(1); _Pragma("unroll") for (int m = 0; m < 4; ++m) _Pragma("unroll") for (int n = 0; n < 2; ++n) { \
        if constexpr (FP8) asm volatile("v_mfma_scale_f32_16x16x128_f8f6f4 %0, %1, %2, %0, %3, %4 op_sel_hi:[0,0,0]" : "+v"(acc[ai][bj][m][n]) : "v"(Bt##8[n]), "v"(At##8[m]), "v"(sclW), "v"(sclX)); \
        else { _Pragma("unroll") for (int k = 0; k < 2; ++k) acc[ai][bj][m][n] = __builtin_amdgcn_mfma_f32_16x16x32_bf16(Bt[n][k], At[m][k], acc[ai][bj][m][n], 0, 0, 0); } } \
        __builtin_amdgcn_s_setprio(0); } while (0)
#define PG8_WAIT_V(n) asm volatile("s_waitcnt vmcnt(" #n ")" ::: "memory")
#define PG8_WAIT_L(n) asm volatile("s_waitcnt lgkmcnt(" #n ")" ::: "memory")
#define PG8_BAR __builtin_amdgcn_s_barrier()
#define PG8_SCHED __builtin_amdgcn_sched_barrier(0)
    Unit cur, nxt; int ui = 0;
    if (!S.next(0, cur)) return;
    f32x4 acc[2][2][4][2];
#pragma unroll
    for (int a = 0; a < 2; ++a)
#pragma unroll
        for (int b = 0; b < 2; ++b)
#pragma unroll
            for (int m = 0; m < 4; ++m)
#pragma unroll
                for (int n = 0; n < 2; ++n) acc[a][b][m][n] = (f32x4){0.f, 0.f, 0.f, 0.f};
    typedef int v4i_ __attribute__((ext_vector_type(4))); typedef int v8i_ __attribute__((ext_vector_type(8)));
    const int sclW = 0x7B7B7B7B, sclX = 0x7F7F7F7F;
    bf16x8 At[4][2], B0[2][2], B1[2][2]; v8i_ At8[4], B08[2], B18[2];
    const char* cA = (const char*)g.A + (size_t)cur.pm * tstepA + (size_t)cur.pn * pnoffA; const char* cB = (const char*)g.Bt + (size_t)cur.pn * tstep;
    S.a_ready(cur);
    if constexpr (SP2) {
        PG8_STAGE(PG8_SB(0, 0), cB, voffB); PG8_STAGE(PG8_SB(0, 1), cB + hstep, voffB); PG8_STAGE(PG8_SA(0, 0), cA, voffA); PG8_STAGE(PG8_SA(0, 1), cA + hstepA, voffA);
        if (wr == 1) PG8_BAR;
        PG8_WAIT_V(2); PG8_BAR;
        PG8_STAGE(PG8_SB(1, 0), cB + kstep, voffB); PG8_STAGE(PG8_SA(1, 0), cA + kstep, voffA); PG8_STAGE(PG8_SB(1, 1), cB + hstep + kstep, voffB);
        PG8_WAIT_V(6); PG8_BAR;
    } else {
        PG8_STAGE(PG8_SB(0, 0), cB, voffB); PG8_STAGE(PG8_SA(0, 0), cA, voffA); PG8_STAGE(PG8_SB(0, 1), cB + hstep, voffB); PG8_STAGE(PG8_SA(0, 1), cA + hstepA, voffA);
        if (wr == 1) PG8_BAR;
        PG8_WAIT_V(4); PG8_BAR;
        PG8_STAGE(PG8_SB(1, 0), cB + kstep, voffB); PG8_STAGE(PG8_SA(1, 0), cA + kstep, voffA); PG8_STAGE(PG8_SB(1, 1), cB + hstep + kstep, voffB);
        PG8_WAIT_V(6); PG8_BAR;
    }
    for (;;) {
        const bool has_next = S.next(ui + 1, nxt);
        const char* nA = has_next ? (const char*)g.A + (size_t)nxt.pm * tstepA + (size_t)nxt.pn * pnoffA : cA; const char* nB = has_next ? (const char*)g.Bt + (size_t)nxt.pn * tstep : cB;
#pragma nounroll
        for (int t = 0; t < nt; t += 2) {
            const bool last = (t == nt - 2);
            const char* a1 = cA + (size_t)(t + 1) * kstep;
            const char* a2 = last ? nA : cA + (size_t)(t + 2) * kstep; const char* b2 = last ? nB : cB + (size_t)(t + 2) * kstep;
            const char* a3 = a2 + kstep; const char* b3 = b2 + kstep;
            if (last && has_next) S.a_ready(nxt);
            if constexpr (SP2) {
            PG8_LDB(B0, 0, 0); PG8_LDB(B1, 0, 1); PG8_SCHED; PG8_LDA(At, 0, 0); PG8_STAGE(PG8_SA(1, 1), a1 + hstepA, voffA);
            PG8_WAIT_V(8); PG8_WAIT_L(0); PG8_BAR; PG8_MMA(0, 0, At, B0); PG8_MMA(0, 1, At, B1); PG8_BAR; PG8_SCHED;
            PG8_LDA(At, 0, 1); PG8_STAGE(PG8_SB(0, 0), b2, voffB); PG8_STAGE(PG8_SB(0, 1), b2 + hstep, voffB); PG8_STAGE(PG8_SA(0, 0), a2, voffA);
            PG8_WAIT_V(8); PG8_WAIT_L(0); PG8_BAR; PG8_MMA(1, 0, At, B0); PG8_MMA(1, 1, At, B1); PG8_BAR; PG8_SCHED;
            PG8_LDB(B0, 1, 0); PG8_LDB(B1, 1, 1); PG8_SCHED; PG8_LDA(At, 1, 0); PG8_STAGE(PG8_SA(0, 1), a2 + hstepA, voffA);
            PG8_WAIT_V(8); PG8_WAIT_L(0); PG8_BAR; PG8_MMA(0, 0, At, B0); PG8_MMA(0, 1, At, B1); PG8_BAR; PG8_SCHED;
            PG8_LDA(At, 1, 1); PG8_STAGE(PG8_SB(1, 0), b3, voffB); PG8_STAGE(PG8_SB(1, 1), b3 + hstep, voffB); PG8_STAGE(PG8_SA(1, 0), a3, voffA);
            PG8_WAIT_V(8); PG8_WAIT_L(0); PG8_BAR; PG8_MMA(1, 0, At, B0); PG8_MMA(1, 1, At, B1); PG8_BAR; PG8_SCHED;
            } else {
            PG8_LDB(B0, 0, 0); PG8_SCHED; PG8_LDA(At, 0, 0); PG8_STAGE(PG8_SA(1, 1), a1 + hstepA, voffA);
            PG8_WAIT_L(8); PG8_BAR; PG8_WAIT_L(0); PG8_MMA(0, 0, At, B0); PG8_BAR; PG8_SCHED;
            PG8_LDB(B1, 0, 1); PG8_STAGE(PG8_SB(0, 0), b2, voffB);
            PG8_BAR; PG8_WAIT_L(0); PG8_MMA(0, 1, At, B1); PG8_BAR;
            PG8_LDA(At, 0, 1); PG8_STAGE(PG8_SA(0, 0), a2, voffA);
            PG8_BAR; PG8_WAIT_L(0); PG8_MMA(1, 0, At, B0); PG8_BAR; PG8_SCHED;
            PG8_STAGE(PG8_SB(0, 1), b2 + hstep, voffB);
            PG8_WAIT_V(6); PG8_BAR; PG8_MMA(1, 1, At, B1); PG8_BAR;
            PG8_LDB(B0, 1, 0); PG8_SCHED; PG8_LDA(At, 1, 0); PG8_STAGE(PG8_SA(0, 1), a2 + hstepA, voffA);
            PG8_WAIT_L(8); PG8_BAR; PG8_WAIT_L(0); PG8_MMA(0, 0, At, B0); PG8_BAR; PG8_SCHED;
            PG8_LDB(B1, 1, 1); PG8_STAGE(PG8_SB(1, 0), b3, voffB);
            PG8_BAR; PG8_WAIT_L(0); PG8_MMA(0, 1, At, B1); PG8_BAR;
            PG8_LDA(At, 1, 1); PG8_STAGE(PG8_SA(1, 0), a3, voffA);
            PG8_BAR; PG8_WAIT_L(0); PG8_MMA(1, 0, At, B0); PG8_BAR; PG8_SCHED;
            PG8_STAGE(PG8_SB(1, 1), b3 + hstep, voffB);
            PG8_WAIT_V(6); PG8_BAR; PG8_MMA(1, 1, At, B1); PG8_BAR;
            }
        }
        if constexpr (FP8) asm volatile("s_nop 15\n\ts_nop 7" ::: "memory");
        if constexpr (ALIGN_EPI) { if (wr == 0) PG8_BAR; }
        if constexpr (!Epi::AFTER_DRAIN) { E(acc, cur, wr, wc, fr, fq); S.done(cur); }
        if (!has_next) break;
#pragma unroll
        for (int a = 0; a < 2; ++a)
#pragma unroll
            for (int b = 0; b < 2; ++b)
#pragma unroll
                for (int m = 0; m < 4; ++m)
#pragma unroll
                    for (int n = 0; n < 2; ++n) acc[a][b][m][n] = (f32x4){0.f, 0.f, 0.f, 0.f};
        cur = nxt; cA = nA; cB = nB; ++ui;
        if constexpr (ALIGN_EPI) { if (wr == 1) PG8_BAR; }
    }
    PG8_WAIT_V(0);
    if constexpr (!ALIGN_EPI) { if (wr == 0) PG8_BAR; }
    PG8_BAR;
    if constexpr (Epi::AFTER_DRAIN) { E.fused(acc, cur, wr, wc, fr, fq, lds, wid, lane); S.done(cur); }
#undef PG8_SA
#undef PG8_SB
#undef PG8_STAGE
#undef PG8_LDA
#undef PG8_LDB
#undef PG8_MMA
#undef PG8_WAIT_V
#undef PG8_WAIT_L
#undef PG8_BAR
#undef PG8_SCHED
}
}

typedef GAS unsigned gu32;
typedef GAS unsigned long long gu64;
#define RLX_AGENT __ATOMIC_RELAXED, __HIP_MEMORY_SCOPE_AGENT
#define LDS_WAIT() asm volatile("s_waitcnt lgkmcnt(0)" ::: "memory")
#define VM_WAIT() asm volatile("s_waitcnt vmcnt(0)" ::: "memory")
__device__ __forceinline__ unsigned long long rt() { return __builtin_amdgcn_s_memrealtime(); }

#define XB_TMO      128
#define XB_XCNT(j)  (256  + 64 * (j))
#define XB_XSUB(j)  (1280 + 64 * (j))
#define XB_XGEN(j)  (2304 + 64 * (j))
#define XB_TOP      3328
#define XB_TOPGEN   3392
#define XCD_BAR_WORDS 3456
#define XB_SPIN_CAP (1u << 18)

__device__ __forceinline__ unsigned xb_ld(unsigned* p)              { return __hip_atomic_load(p, __ATOMIC_RELAXED, __HIP_MEMORY_SCOPE_AGENT); }
__device__ __forceinline__ unsigned xb_add(unsigned* p, unsigned v) { return __hip_atomic_fetch_add(p, v, __ATOMIC_RELAXED, __HIP_MEMORY_SCOPE_AGENT); }
__device__ __forceinline__ unsigned xb_xcc_id() { return (unsigned)__builtin_amdgcn_s_getreg((3 << 11) | 20) & 0xFu; }
#define XB_SPIN(cond, bar) do { unsigned _sp = 0; while (cond) { __builtin_amdgcn_s_sleep(1); \
    if ((++_sp & 255u) == 0u) { if (xb_ld(&(bar)[XB_TMO])) break; if (_sp > XB_SPIN_CAP) { atomicAdd(&(bar)[XB_TMO], 1u); break; } } } } while (0)

struct XcdBarrier {
    unsigned* bar; unsigned x;
    volatile LAS unsigned* st;
};

__device__ __forceinline__ XcdBarrier xcd_barrier_post(unsigned* bar, volatile LAS unsigned* st) {
    XcdBarrier b; b.bar = bar; b.x = xb_xcc_id(); b.st = st;
    if (threadIdx.x == 0) (void)xb_add(&bar[XB_XCNT(b.x)], 1u);
    return b;
}
__device__ __forceinline__ void xcd_barrier_complete(unsigned* bar, unsigned x, unsigned& nloc, unsigned& nx) {
    const unsigned G = gridDim.x * gridDim.y * gridDim.z;
    unsigned sum, cnt, mine, sp = 0u;
    for (;;) {
        sum = 0u; cnt = 0u; mine = 0u;
#pragma unroll
        for (unsigned j = 0; j < 16; ++j) { const unsigned c = xb_ld(&bar[XB_XCNT(j)]); sum += c; cnt += (c > 0u) ? 1u : 0u; mine = (j == x) ? c : mine; }
        if (sum == G) break;
        __builtin_amdgcn_s_sleep(1);
        if ((++sp & 255u) == 0u) { if (xb_ld(&bar[XB_TMO])) break; if (sp > XB_SPIN_CAP) { atomicAdd(&bar[XB_TMO], 1u); break; } }
    }
    nloc = mine > 0u ? mine : 1u; nx = cnt > 0u ? cnt : 1u;
}

__device__ __forceinline__ void xcd_barrier(const XcdBarrier& b) {
    asm volatile("s_waitcnt vmcnt(0)" ::: "memory");
    __syncthreads();
    if (threadIdx.x == 0) {
        unsigned* bar = b.bar;
        __builtin_amdgcn_s_waitcnt(0);
        unsigned nloc = b.st[0], nx = b.st[1];
        if (nloc == 0u) { xcd_barrier_complete(bar, b.x, nloc, nx); b.st[0] = nloc; b.st[1] = nx; }
        const unsigned old = xb_add(&bar[XB_XSUB(b.x)], 1u);
        const unsigned gen = old / nloc;
        if (old + 1u == (gen + 1u) * nloc) {
            __builtin_amdgcn_fence(__ATOMIC_RELEASE, "agent");
            asm volatile("s_waitcnt vmcnt(0)" ::: "memory");
            const unsigned og = xb_add(&bar[XB_TOP], 1u);
            const unsigned tg = og / nx;
            if (og + 1u == (tg + 1u) * nx) xb_add(&bar[XB_TOPGEN], 1u);
            else XB_SPIN(xb_ld(&bar[XB_TOPGEN]) == tg, bar);
            __builtin_amdgcn_fence(__ATOMIC_ACQUIRE, "agent");
            xb_add(&bar[XB_XGEN(b.x)], 1u);
            asm volatile("s_waitcnt vmcnt(0)" ::: "memory");
        } else {
            XB_SPIN(xb_ld(&bar[XB_XGEN(b.x)]) == gen, bar);
            __builtin_amdgcn_fence(__ATOMIC_ACQUIRE, "agent");
            asm volatile("s_waitcnt vmcnt(0)" ::: "memory");
        }
    }
    __syncthreads();
}


struct Params {
    const float* x; const float* rel_bias; const float* ln_attn; const float* ln_mlp; const float* moba_w_qkv; const float* moba_w_o; const float* dsa_w_in; const float* dsa_g_q; const float* dsa_g_kv;
    const float* dsa_w_uq; const float* dsa_w_qi; const float* dsa_w_uk; const float* dsa_w_uv; const float* dsa_w_o; const float* mlp_w_up; const float* mlp_w_down; const float* final_norm;
    float* out; unsigned char* ws;
};
constexpr int NWAVES = 8, NTHR = NWAVES * 64;
constexpr int LDS_BYTES = 163840;
constexpr int LDSCTL_OFF = LDS_BYTES - 512;

__device__ __forceinline__ float wave_sum(float v) {
#pragma unroll
    for (int o = 1; o < 64; o <<= 1) v += __shfl_xor(v, o);
    return v;
}
__device__ __forceinline__ float wave_max(float v) {
#pragma unroll
    for (int o = 1; o < 64; o <<= 1) v = fmaxf(v, __shfl_xor(v, o));
    return v;
}

__device__ __forceinline__ void p0_transpose_item(const float* W, const float* gain, int K, int N, int Npad, bf16_t* WT, int row_off, LAS float* scr, int item, int lane) {
    const int nblk = Npad / 32, kb = item / nblk, nb = item % nblk, k0 = 64 * kb, n0 = 32 * nb;
    { const int n = n0 + (lane & 31); const bool nok = n < N; float v[32];
#pragma unroll
      for (int i = 0; i < 32; ++i) { const int kk = 2 * i + (lane >> 5); v[i] = nok ? W[(size_t)(k0 + kk) * N + n] : 0.f; }
      if (gain) {
#pragma unroll
          for (int i = 0; i < 32; ++i) v[i] *= gain[k0 + 2 * i + (lane >> 5)]; }
#pragma unroll
      for (int i = 0; i < 32; ++i) scr[(2 * i + (lane >> 5)) * 33 + (lane & 31)] = v[i]; }
    asm volatile("s_waitcnt lgkmcnt(0)" ::: "memory");
    const int c = lane & 7;
#pragma unroll
    for (int j = 0; j < 4; ++j) { const int n = (lane >> 3) + 8 * j; const LAS float* s = scr + (8 * c) * 33 + n;
        u32x4 o; o.x = pk2(s[0 * 33], s[1 * 33]); o.y = pk2(s[2 * 33], s[3 * 33]); o.z = pk2(s[4 * 33], s[5 * 33]); o.w = pk2(s[6 * 33], s[7 * 33]);
        *(u32x4*)(WT + (size_t)(row_off + n0 + n) * K + k0 + 8 * c) = o; }
    asm volatile("s_waitcnt lgkmcnt(0)" ::: "memory");
}
__device__ __forceinline__ void p0_transpose_item8(const float* W, const float* gain, int K, int N, unsigned char* WT, int row_off, LAS float* scr, int item, int lane) {
    const int nblk = N / 32, kb = item / nblk, nb = item % nblk, k0 = 64 * kb, n0 = 32 * nb;
    { const int n = n0 + (lane & 31); float v[32];
#pragma unroll
      for (int i = 0; i < 32; ++i) { const int kk = 2 * i + (lane >> 5); v[i] = W[(size_t)(k0 + kk) * N + n] * 16.0f; }
      if (gain) {
#pragma unroll
          for (int i = 0; i < 32; ++i) v[i] *= gain[k0 + 2 * i + (lane >> 5)]; }
#pragma unroll
      for (int i = 0; i < 32; ++i) scr[(2 * i + (lane >> 5)) * 33 + (lane & 31)] = v[i]; }
    asm volatile("s_waitcnt lgkmcnt(0)" ::: "memory");
    const int c = lane & 3;
#pragma unroll
    for (int j = 0; j < 2; ++j) { const int n = (lane >> 2) + 16 * j; const LAS float* s = scr + (16 * c) * 33 + n; u32x4 o;
#pragma unroll
        for (int q = 0; q < 4; ++q) { int t = __builtin_amdgcn_cvt_pk_fp8_f32(s[(4 * q) * 33], s[(4 * q + 1) * 33], 0, false); t = __builtin_amdgcn_cvt_pk_fp8_f32(s[(4 * q + 2) * 33], s[(4 * q + 3) * 33], t, true); o[q] = (unsigned)t; }
        *(u32x4*)(WT + (size_t)(row_off + n0 + n) * K + k0 + 16 * c) = o; }
    asm volatile("s_waitcnt lgkmcnt(0)" ::: "memory");
}
__device__ __forceinline__ void p0_prologue(const Params& P, LAS unsigned char* lds, int vcu, int G, int which) {
    const int tid = threadIdx.x, lane = tid & 63, wave = __builtin_amdgcn_readfirstlane(tid >> 6);
    unsigned char* ws = P.ws;
    LAS float* scr = (LAS float*)(lds + wave * 16384);
    const int gw = vcu * NWAVES + wave, NGW = G * NWAVES;
    constexpr int I_QKV = (DM / 64) * (3 * DM / 32), I_O = (DM / 64) * (DM / 32), I_UP = (DM / 64) * (FF / 32), I_DN = (FF / 64) * (DM / 32), I_IN = (DM / 64) * (DSA_IN_PAD / 32), I_QI = (DQ / 64) * (512 / 32);
    const bool do0 = (which == 0 || which == 2), do1 = (which == 1 || which == 2);
    if (which != 1) {
        constexpr int N0 = I_QKV + I_O + I_UP + I_DN + I_IN;
        const int it_lo = (which == 3) ? I_QKV : 0, it_hi = (which == 0) ? I_QKV : N0;
        for (int it = it_lo + gw; it < it_hi; it += NGW) {
            int r = it;
            if (r < I_QKV) { p0_transpose_item8(P.moba_w_qkv, P.ln_attn, DM, 3 * DM, (unsigned char*)(ws + WS_WQKV0), 0, scr, r, lane); continue; } r -= I_QKV;
            if (r < I_O) { p0_transpose_item8(P.moba_w_o, nullptr, DM, DM, (unsigned char*)(ws + WS_WO0), 0, scr, r, lane); continue; } r -= I_O;
            if (r < I_UP) { p0_transpose_item(P.mlp_w_up, P.ln_mlp, DM, FF, FF, (bf16_t*)(ws + WS_WUP0), 0, scr, r, lane); continue; } r -= I_UP;
            if (r < I_DN) { p0_transpose_item(P.mlp_w_down, nullptr, FF, DM, DM, (bf16_t*)(ws + WS_WDN0), 0, scr, r, lane); continue; } r -= I_DN;
            p0_transpose_item(P.dsa_w_in, P.ln_attn + DM, DM, DSA_IN, DSA_IN_PAD, (bf16_t*)(ws + WS_WIN1), 0, scr, r, lane);
        }
    }
    if (do1) {
        constexpr int N1 = I_O + I_UP + I_DN + I_QI;
        for (int it = gw; it < N1; it += NGW) {
            int r = it;
            if (r < I_O) { p0_transpose_item8(P.dsa_w_o, nullptr, DM, DM, (unsigned char*)(ws + WS_WO1), 0, scr, r, lane); continue; } r -= I_O;
            if (r < I_UP) { p0_transpose_item(P.mlp_w_up + (size_t)DM * FF, P.ln_mlp + DM, DM, FF, FF, (bf16_t*)(ws + WS_WUP1), 0, scr, r, lane); continue; } r -= I_UP;
            if (r < I_DN) { p0_transpose_item(P.mlp_w_down + (size_t)FF * DM, nullptr, FF, DM, DM, (bf16_t*)(ws + WS_WDN1), 0, scr, r, lane); continue; } r -= I_DN;
            p0_transpose_item(P.dsa_w_qi, P.dsa_g_q, DQ, 512, 512, (bf16_t*)(ws + WS_WQI), 0, scr, r, lane);
        }
    }
    const int gt = vcu * NTHR + tid, NGT = G * NTHR;
    if (do1)
    for (int it = gt; it < NH * DC * (DQ / 16); it += NGT) {
        const int c = it & 255, h = (it >> 8) & 15, k16 = (it >> 12) * 16;
        float a[16];
#pragma unroll
        for (int i = 0; i < 16; ++i) a[i] = 0.f;
        const float* uk = P.dsa_w_uk + (size_t)h * HD * DC + c; const float* uq = P.dsa_w_uq + (size_t)k16 * DM + h * HD;
        for (int d = 0; d < HD; ++d) { const float w = uk[(size_t)d * DC];
#pragma unroll
            for (int i = 0; i < 16; ++i) a[i] += uq[(size_t)i * DM + d] * w; }
#pragma unroll
        for (int i = 0; i < 16; ++i) a[i] *= 16.0f * C2 * P.dsa_g_q[k16 + i];
        u32x4 o;
#pragma unroll
        for (int q = 0; q < 4; ++q) { int t = __builtin_amdgcn_cvt_pk_fp8_f32(a[4 * q], a[4 * q + 1], 0, false); t = __builtin_amdgcn_cvt_pk_fp8_f32(a[4 * q + 2], a[4 * q + 3], t, true); o[q] = (unsigned)t; }
        *(u32x4*)((unsigned char*)(ws + WS_WQ1) + (size_t)(h * DC + c) * DQ + k16) = o;
    }
    if (do1)
    for (int it = gt; it < DM * (DM / 16); it += NGT) {
        const int n = it & 1023, kl16 = (it >> 10) * 16, h = n >> 6, d = n & 63, hh = kl16 >> 8, c16 = kl16 & 255;
        u32x4 o = (u32x4){0u, 0u, 0u, 0u};
        if (hh == (h & 3)) { const float* uv = P.dsa_w_uv + ((size_t)h * DC + c16) * HD + d;
#pragma unroll
            for (int q = 0; q < 4; ++q) { int t = __builtin_amdgcn_cvt_pk_fp8_f32(16.0f * uv[(4 * q) * HD], 16.0f * uv[(4 * q + 1) * HD], 0, false); t = __builtin_amdgcn_cvt_pk_fp8_f32(16.0f * uv[(4 * q + 2) * HD], 16.0f * uv[(4 * q + 3) * HD], t, true); o[q] = (unsigned)t; } }
        *(u32x4*)((unsigned char*)(ws + WS_WUVB) + (size_t)n * DM + kl16) = o;
    }
    if (do0)
    for (int it = gt; it < 128 * NH; it += NGT) { const int d = it >> 4, h = it & 15; ((float*)(ws + WS_LUT))[it] = P.rel_bias[BUCKET_TAB[d] * NH + h] * LOG2E; }
    if (do0)
    for (int m0 = gw * 4; m0 < T; m0 += NGW * 4) {
        f32x4 v[4][4];
#pragma unroll
        for (int r = 0; r < 4; ++r)
#pragma unroll
            for (int j = 0; j < 4; ++j) v[r][j] = ((const f32x4*)(P.x + (size_t)(m0 + r) * DM) + lane)[64 * j];
#pragma unroll
        for (int r = 0; r < 4; ++r) { float s = 0.f; unsigned* o4 = (unsigned*)((unsigned char*)(ws + WS_XB) + (size_t)(m0 + r) * DM) + lane;
#pragma unroll
            for (int j = 0; j < 4; ++j) { s += sumsq4(v[r][j]); int t = __builtin_amdgcn_cvt_pk_fp8_f32(v[r][j][0], v[r][j][1], 0, false); t = __builtin_amdgcn_cvt_pk_fp8_f32(v[r][j][2], v[r][j][3], t, true); o4[64 * j] = (unsigned)t; }
            s = wave_sum(s);
            if (lane < 16) ((float*)(ws + WS_SSP))[(size_t)(m0 + r) * 16 + lane] = (lane == 0) ? s : 0.f; }
    }
}
__device__ __forceinline__ void ckv_norm(const Params& P, int vcu, int G) {
    const int tid = threadIdx.x, lane = tid & 63, wave = __builtin_amdgcn_readfirstlane(tid >> 6);
    const int gw = vcu * NWAVES + wave, NGW = G * NWAVES; unsigned char* ws = P.ws;
    const f32x4 g = ((const f32x4*)P.dsa_g_kv)[lane];
    for (int m = gw; m < T; m += NGW) {
        const f32x4 p = *(const f32x4*)((const float*)(ws + WS_SSQ) + (size_t)m * 8 + 4);
        const float rs = 1.0f / sqrtf(((p[0] + p[1]) + (p[2] + p[3])) * (1.0f / 256.0f) + EPS);
        const f32x4 v = ((const f32x4*)((const float*)(ws + WS_CKV) + (size_t)m * DC))[lane] * rs * g;
        int w = __builtin_amdgcn_cvt_pk_fp8_f32(v[0], v[1], 0, false); w = __builtin_amdgcn_cvt_pk_fp8_f32(v[2], v[3], w, true);
        ((unsigned*)((unsigned char*)(ws + WS_CKV8) + (size_t)m * DC))[lane] = (unsigned)w;
    }
}
__device__ __forceinline__ void final_norm(const Params& P, int vcu, int G) {
    const int tid = threadIdx.x, lane = tid & 63, wave = __builtin_amdgcn_readfirstlane(tid >> 6);
    const int gw = vcu * NWAVES + wave, NGW = G * NWAVES; unsigned char* ws = P.ws;
    f32x4 g[4];
#pragma unroll
    for (int j = 0; j < 4; ++j) g[j] = ((const f32x4*)P.final_norm)[lane + 64 * j];
    for (int m0 = gw * 4; m0 < T; m0 += NGW * 4) {
        u32x2 v[4][4]; float rs[4];
#pragma unroll
        for (int r = 0; r < 4; ++r) { rs[r] = pg8::row_rstd16((const float*)(ws + WS_SSP), m0 + r);
#pragma unroll
            for (int j = 0; j < 4; ++j) v[r][j] = ((const u32x2*)((const bf16_t*)(ws + WS_XB) + (size_t)(m0 + r) * DM) + lane)[64 * j]; }
#pragma unroll
        for (int r = 0; r < 4; ++r)
#pragma unroll
            for (int j = 0; j < 4; ++j) { const f32x4 x = (f32x4){bflo(v[r][j].x), bfhi(v[r][j].x), bflo(v[r][j].y), bfhi(v[r][j].y)};
                ((f32x4*)(P.out + (size_t)(m0 + r) * DM) + lane)[64 * j] = x * rs[r] * g[j]; }
    }
}

namespace moba {
typedef float f32x16 __attribute__((ext_vector_type(16)));
typedef int v8i __attribute__((ext_vector_type(8)));
typedef int v2i __attribute__((ext_vector_type(2)));
constexpr int SLOT = 4096;
constexpr int L_K = 0, L_V = 2 * SLOT, L_LUT = 4 * SLOT, L_OST = L_LUT + 2560, L_END = L_OST + 8 * 2048;
constexpr float NEGBIG = -1.0e30f;
__device__ __forceinline__ int crow(int r, int hi) { return (r & 3) + 8 * (r >> 2) + 4 * hi; }
__device__ __forceinline__ unsigned cvtpk(float lo, float hi) { typedef __bf16 bf2 __attribute__((ext_vector_type(2))); f32x2 v = {lo, hi}; bf2 b = __builtin_convertvector(v, bf2); return __builtin_bit_cast(unsigned, b); }
__device__ __forceinline__ int pk4(float a, float b, float c, float d) { int w = __builtin_amdgcn_cvt_pk_fp8_f32(a, b, 0, false); return __builtin_amdgcn_cvt_pk_fp8_f32(c, d, w, true); }
__device__ __forceinline__ f32x16 mma8(const v8i a, const v8i b, const f32x16 c, int sa, int sb) { return __builtin_amdgcn_mfma_scale_f32_32x32x64_f8f6f4(a, b, c, 0, 0, 0, sa, 0, sb); }

__device__ __forceinline__ void unit(const Params& P, LAS unsigned char* lds, int b, int h, int j) {
    const int tid = threadIdx.x, lane = tid & 63, r32 = lane & 31, hi = lane >> 5; const int wid = __builtin_amdgcn_readfirstlane(tid >> 6);
    unsigned char* ws = P.ws;
    const unsigned char* Q8 = (const unsigned char*)(ws + WS_BIG); const unsigned char* K8 = Q8 + (size_t)T * DM; const unsigned char* V8 = K8 + (size_t)T * DM;
    const size_t rowbase = (size_t)b * SEQ; const int q0 = j * MBLK;
    LAS float* lut = (LAS float*)(lds + L_LUT);
    __syncthreads();
    for (int t_ = tid; t_ < 640; t_ += NTHR) lut[t_] = (t_ < 128) ? NEGBIG : ((const float*)(ws + WS_LUT))[((t_ - 128) < 127 ? (t_ - 128) : 127) * NH + h];
    const int w4 = wid & 3, skey = 16 * w4 + (lane >> 2), spc = lane & 3, slc = spc ^ ((skey >> 2) & 3);
    const unsigned char* ssrc = (wid < 4 ? K8 : V8) + (rowbase + skey) * DM + h * HD + slc * 16;
    const int sdst = (wid < 4 ? L_K : L_V) + w4 * 1024;
    const int nt = 4 * (j + 1);
#define MOBA_TROW(i) (((i) < 4) ? (q0 + (i) * 64) : ((j - 1 - (((i) - 4) >> 2)) * MBLK + (((i) - 4) & 3) * 64))
#define MOBA_ISSUE(i) do { const int _tr = MOBA_TROW(i); \
        __builtin_amdgcn_global_load_lds((const unsigned*)(ssrc + (size_t)_tr * DM), (LAS unsigned*)(lds + sdst + ((i) & 1) * SLOT), 16, 0, 0); } while (0)
    MOBA_ISSUE(0);
    v8i qb;
    { const unsigned char* qp = Q8 + (rowbase + q0 + wid * 32 + r32) * DM + h * HD + 32 * hi; const u32x4 a = *(const u32x4*)qp, c = *(const u32x4*)(qp + 16);
      qb = (v8i){(int)a.x, (int)a.y, (int)a.z, (int)a.w, (int)c.x, (int)c.y, (int)c.z, (int)c.w}; }
    unsigned sel = 0u;
    if (j > 0) {
        f32x16 G;
#pragma unroll
        for (int r = 0; r < 16; ++r) G[r] = 0.f;
        const float* ks0 = (const float*)(ws + WS_KSUM) + ((size_t)((b * NBLK + r32) * 2)) * DM + h * HD + 32 * hi;
#pragma unroll
        for (int d0 = 0; d0 < 4; ++d0) {
            float kv[8];
            if (r32 < j) { const f32x4 a0 = *(const f32x4*)(ks0 + d0 * 8), a1 = *(const f32x4*)(ks0 + d0 * 8 + 4), c0 = *(const f32x4*)(ks0 + DM + d0 * 8), c1 = *(const f32x4*)(ks0 + DM + d0 * 8 + 4);
#pragma unroll
                for (int e = 0; e < 4; ++e) { kv[e] = a0[e] + c0[e]; kv[4 + e] = a1[e] + c1[e]; } }
            else {
#pragma unroll
                for (int e = 0; e < 8; ++e) kv[e] = 0.f; }
            bf16x8 ah, al;
#pragma unroll
            for (int e = 0; e < 8; ++e) { const unsigned hb = f2bf(kv[e]); ah[e] = (short)hb; al[e] = (short)f2bf(kv[e] - bf2f(hb)); }
            const f32x2 q01 = __builtin_amdgcn_cvt_pk_f32_fp8(qb[2 * d0], false), q23 = __builtin_amdgcn_cvt_pk_f32_fp8(qb[2 * d0], true), q45 = __builtin_amdgcn_cvt_pk_f32_fp8(qb[2 * d0 + 1], false), q67 = __builtin_amdgcn_cvt_pk_f32_fp8(qb[2 * d0 + 1], true);
            const u32x4 qw = {cvtpk(q01[0], q01[1]), cvtpk(q23[0], q23[1]), cvtpk(q45[0], q45[1]), cvtpk(q67[0], q67[1])};
            const bf16x8 qf = __builtin_bit_cast(bf16x8, qw);
            G = __builtin_amdgcn_mfma_f32_32x32x16_bf16(ah, qf, G, 0, 0, 0);
            G = __builtin_amdgcn_mfma_f32_32x32x16_bf16(al, qf, G, 0, 0, 0);
        }
        float a[8], bs[8], g16[16];
#pragma unroll
        for (int r = 0; r < 8; ++r) { a[r] = G[r]; bs[r] = __shfl_xor(a[r], 32); }
#pragma unroll
        for (int i = 0; i < 4; ++i) { g16[i] = hi ? bs[i] : a[i]; g16[4 + i] = hi ? a[i] : bs[i]; g16[8 + i] = hi ? bs[4 + i] : a[4 + i]; g16[12 + i] = hi ? a[4 + i] : bs[4 + i]; }
#pragma unroll
        for (int n = 0; n < 15; ++n) { if (n < j) { int rank = 0;
#pragma unroll
                for (int m = 0; m < 15; ++m) { if (m != n && m < j) rank += (g16[m] > g16[n] || (g16[m] == g16[n] && m < n)) ? 1 : 0; }
                if (rank < 3) sel |= 1u << n; } }
    }
    float m_ref = 0.f, lsum = 0.f; f32x16 o0, o1, cin;
#pragma unroll
    for (int r = 0; r < 16; ++r) { o0[r] = 0.f; o1[r] = 0.f; cin[r] = 0.f; }
    const int SC1 = 0x7F7F7F7F, SCQ = 0x7C7C7C7C;
    const int ksw = (r32 >> 2) & 3; const int kofa = r32 * 64 + (((2 * hi) ^ ksw) << 4), kofb = r32 * 64 + (((2 * hi + 1) ^ ksw) << 4);
    const int l15 = lane & 15, r8 = l15 >> 1, p2 = l15 & 1, dsel = (lane >> 4) & 1;
    const int vkey0 = (r8 & 3) + 8 * (r8 >> 2) + 4 * hi, vsw = (vkey0 >> 2) & 3;
    const int vof0 = vkey0 * 64 + ((dsel ^ vsw) << 4) + 8 * p2, vof1 = vkey0 * 64 + (((2 + dsel) ^ vsw) << 4) + 8 * p2;
    const float b31 = ((const float*)(ws + WS_LUT))[127 * NH + h];
    for (int i = 0; i < nt; ++i) {
        asm volatile("s_waitcnt vmcnt(0)" ::: "memory"); __syncthreads();
        if (i + 1 < nt) MOBA_ISSUE(i + 1);
        const bool own = i < 4; const int blk = own ? j : j - 1 - ((i - 4) >> 2); const int tt = own ? i : ((i - 4) & 3);
        const bool rowsel = own || ((sel >> blk) & 1u);
        const bool active = own ? (tt * 64 <= wid * 32 + 31) : (__any(rowsel) != 0);
        if (!active) continue;
        const bool near = own || (blk == j - 1 && tt >= 2);
        if (own || tt == 0 || (blk == j - 1 && tt == 2)) {
            const float cv = rowsel ? ((near ? 0.f : b31) - m_ref) : NEGBIG;
#pragma unroll
            for (int r = 0; r < 16; ++r) cin[r] = cv; }
        f32x16 p0, p1; float ts;
        const LAS unsigned char* kb = lds + L_K + (i & 1) * SLOT;
        const LAS float* lb = lut + ((j - blk) * MBLK + wid * 32 + r32 - tt * 64 + 128);
#define MOBA_SCORES() do { \
          const u32x4 a0 = *(const LAS u32x4*)(kb + kofa), a1 = *(const LAS u32x4*)(kb + kofb), c0 = *(const LAS u32x4*)(kb + 2048 + kofa), c1 = *(const LAS u32x4*)(kb + 2048 + kofb); \
          p0 = mma8((v8i){(int)a0.x, (int)a0.y, (int)a0.z, (int)a0.w, (int)a1.x, (int)a1.y, (int)a1.z, (int)a1.w}, qb, cin, SC1, SCQ); \
          p1 = mma8((v8i){(int)c0.x, (int)c0.y, (int)c0.z, (int)c0.w, (int)c1.x, (int)c1.y, (int)c1.z, (int)c1.w}, qb, cin, SC1, SCQ); \
          if (near) {                                                          \
              _Pragma("unroll") for (int r = 0; r < 16; ++r) { const float b0_ = lb[-crow(r, hi)], b1_ = lb[-crow(r, hi) - 32]; p0[r] = rowsel ? p0[r] + b0_ : NEGBIG; p1[r] = rowsel ? p1[r] + b1_ : NEGBIG; } } } while (0)
#define MOBA_EXPSUM() do { \
          _Pragma("unroll") for (int r = 0; r < 16; ++r) { p0[r] = __builtin_amdgcn_exp2f(p0[r]); p1[r] = __builtin_amdgcn_exp2f(p1[r]); } \
          f32x2 a2 = {0.f, 0.f}, b2 = {0.f, 0.f};                             \
          _Pragma("unroll") for (int r = 0; r < 16; r += 2) { a2 += (f32x2){p0[r], p0[r + 1]}; b2 += (f32x2){p1[r], p1[r + 1]}; } \
          a2 += b2; ts = a2[0] + a2[1]; } while (0)
        bool redo = (i == 0);
        if (!redo) { MOBA_SCORES(); MOBA_EXPSUM(); redo = __any(!(ts <= 400.0f)) != 0; }
        if (redo) {
            MOBA_SCORES();
#define MX3(a, b, c) __builtin_fmaxf(__builtin_fmaxf((a), (b)), (c))
            float mxa = MX3(p0[0], p0[1], p1[0]), mxb = MX3(p0[2], p0[3], p1[1]); mxa = MX3(mxa, p1[2], p1[3]);
#pragma unroll
            for (int r = 4; r < 16; r += 4) { mxa = MX3(mxa, p0[r], p0[r + 1]); mxb = MX3(mxb, p0[r + 2], p0[r + 3]); mxa = MX3(mxa, p1[r], p1[r + 1]); mxb = MX3(mxb, p1[r + 2], p1[r + 3]); }
#undef MX3
            float mx = fmaxf(mxa, mxb);
            { const auto rr = __builtin_amdgcn_permlane32_swap(__builtin_bit_cast(unsigned, mx), __builtin_bit_cast(unsigned, mx), false, false);
              mx = fmaxf(__builtin_bit_cast(float, (unsigned)rr[0]), __builtin_bit_cast(float, (unsigned)rr[1])); }
            const float dl = (i == 0) ? mx : fmaxf(mx, 0.f); m_ref += dl;
#pragma unroll
            for (int r = 0; r < 16; ++r) { p0[r] -= dl; p1[r] -= dl; cin[r] -= dl; }
            if (i != 0) { const float f = __builtin_amdgcn_exp2f(-dl); lsum *= f;
#pragma unroll
                for (int r = 0; r < 16; ++r) { o0[r] *= f; o1[r] *= f; } }
            MOBA_EXPSUM();
        }
#undef MOBA_SCORES
#undef MOBA_EXPSUM
        lsum += ts;
        const v8i pb = {pk4(p0[0], p0[1], p0[2], p0[3]), pk4(p0[4], p0[5], p0[6], p0[7]), pk4(p0[8], p0[9], p0[10], p0[11]), pk4(p0[12], p0[13], p0[14], p0[15]),
                        pk4(p1[0], p1[1], p1[2], p1[3]), pk4(p1[4], p1[5], p1[6], p1[7]), pk4(p1[8], p1[9], p1[10], p1[11]), pk4(p1[12], p1[13], p1[14], p1[15])};
        { const LAS unsigned char* vb = lds + L_V + (i & 1) * SLOT;
          const v2i x0 = __builtin_amdgcn_ds_read_tr8_b64_v2i32((LAS v2i*)(vb + vof0)), x1 = __builtin_amdgcn_ds_read_tr8_b64_v2i32((LAS v2i*)(vb + vof0 + 1024)),
                    x2 = __builtin_amdgcn_ds_read_tr8_b64_v2i32((LAS v2i*)(vb + vof0 + 2048)), x3 = __builtin_amdgcn_ds_read_tr8_b64_v2i32((LAS v2i*)(vb + vof0 + 3072));
          const v2i y0 = __builtin_amdgcn_ds_read_tr8_b64_v2i32((LAS v2i*)(vb + vof1)), y1 = __builtin_amdgcn_ds_read_tr8_b64_v2i32((LAS v2i*)(vb + vof1 + 1024)),
                    y2 = __builtin_amdgcn_ds_read_tr8_b64_v2i32((LAS v2i*)(vb + vof1 + 2048)), y3 = __builtin_amdgcn_ds_read_tr8_b64_v2i32((LAS v2i*)(vb + vof1 + 3072));
          o0 = mma8((v8i){x0[0], x0[1], x1[0], x1[1], x2[0], x2[1], x3[0], x3[1]}, pb, o0, SC1, SC1);
          o1 = mma8((v8i){y0[0], y0[1], y1[0], y1[1], y2[0], y2[1], y3[0], y3[1]}, pb, o1, SC1, SC1); }
    }
#undef MOBA_ISSUE
#undef MOBA_TROW
    float rl;
    { const auto rr = __builtin_amdgcn_permlane32_swap(__builtin_bit_cast(unsigned, lsum), __builtin_bit_cast(unsigned, lsum), false, false);
      rl = 1.0f / (__builtin_bit_cast(float, (unsigned)rr[0]) + __builtin_bit_cast(float, (unsigned)rr[1])); }
    LAS unsigned char* stg = lds + L_OST + wid * 2048;
#pragma unroll
    for (int r4 = 0; r4 < 4; ++r4) {
        *(LAS int*)(stg + r32 * 64 + 8 * r4 + 4 * hi) = pk4(o0[4 * r4] * rl, o0[4 * r4 + 1] * rl, o0[4 * r4 + 2] * rl, o0[4 * r4 + 3] * rl);
        *(LAS int*)(stg + r32 * 64 + 32 + 8 * r4 + 4 * hi) = pk4(o1[4 * r4] * rl, o1[4 * r4 + 1] * rl, o1[4 * r4 + 2] * rl, o1[4 * r4 + 3] * rl); }
    unsigned char* Ow = (unsigned char*)(ws + WS_O0) + (rowbase + q0 + wid * 32) * DM + h * HD;
#pragma unroll
    for (int i = 0; i < 2; ++i) { const int row = i * 16 + (lane >> 2), ch = lane & 3; const u32x4 v = *(const LAS u32x4*)(stg + row * 64 + ch * 16); *(u32x4*)(Ow + (size_t)row * DM + ch * 16) = v; }
}

__device__ __forceinline__ void phase(const Params& P, LAS unsigned char* lds, int vcu, int G) {
    for (int u = vcu; u < NB * NH * NBLK; u += G) {
        const int i = u >> 8, v = u & 255; const int bh = v >> 1, half = v & 1; const int base = 2 * (i >> 1) + half; const int qb = (i & 1) ? 15 - base : base;
        unit(P, lds, bh >> 4, bh & 15, qb);
    }
    __syncthreads();
}
}
namespace idx {
typedef float f32x16 __attribute__((ext_vector_type(16)));
__device__ __forceinline__ int wave_isum(int v) {
    v += __builtin_amdgcn_update_dpp(0, v, 0x111, 0xf, 0xf, true);
    v += __builtin_amdgcn_update_dpp(0, v, 0x112, 0xf, 0xf, true);
    v += __builtin_amdgcn_update_dpp(0, v, 0x114, 0xf, 0xf, true);
    v += __builtin_amdgcn_update_dpp(0, v, 0x118, 0xf, 0xf, true);
    return (__builtin_amdgcn_readlane(v, 15) + __builtin_amdgcn_readlane(v, 31)) + (__builtin_amdgcn_readlane(v, 47) + __builtin_amdgcn_readlane(v, 63));
}
__device__ __forceinline__ unsigned wave_umax(unsigned v) {
    unsigned t;
    t = (unsigned)__builtin_amdgcn_update_dpp(0, (int)v, 0x111, 0xf, 0xf, true); v = v > t ? v : t;
    t = (unsigned)__builtin_amdgcn_update_dpp(0, (int)v, 0x112, 0xf, 0xf, true); v = v > t ? v : t;
    t = (unsigned)__builtin_amdgcn_update_dpp(0, (int)v, 0x114, 0xf, 0xf, true); v = v > t ? v : t;
    t = (unsigned)__builtin_amdgcn_update_dpp(0, (int)v, 0x118, 0xf, 0xf, true); v = v > t ? v : t;
    const unsigned a = (unsigned)__builtin_amdgcn_readlane((int)v, 15), b = (unsigned)__builtin_amdgcn_readlane((int)v, 31), c = (unsigned)__builtin_amdgcn_readlane((int)v, 47), d = (unsigned)__builtin_amdgcn_readlane((int)v, 63);
    const unsigned ab = a > b ? a : b, cd = c > d ? c : d; return ab > cd ? ab : cd;
}
#define IDX_CNT4(ca, cb, xa, xb, xc, xd) asm volatile( \
    "v_sub_u32_e64 %2, %7, %6 clamp\n\tv_sub_u32_e64 %3, %8, %6 clamp\n\tv_sub_u32_e64 %4, %9, %6 clamp\n\tv_sub_u32_e64 %5, %10, %6 clamp\n\t" \
    "v_min_u32_e32 %2, 1, %2\n\tv_min_u32_e32 %3, 1, %3\n\tv_min_u32_e32 %4, 1, %4\n\tv_min_u32_e32 %5, 1, %5\n\t" \
    "v_add3_u32 %0, %0, %2, %3\n\tv_add3_u32 %1, %1, %4, %5" \
    : "+v"(ca), "+v"(cb), "=&v"(t0_), "=&v"(t1_), "=&v"(t2_), "=&v"(t3_) : "s"(cm1), "v"(xa), "v"(xb), "v"(xc), "v"(xd))
__device__ __forceinline__ int count_ge(const unsigned (&x)[64], unsigned cand_, int nreg) {
    const unsigned cm1 = (unsigned)__builtin_amdgcn_readfirstlane((int)cand_) - 1u;
    unsigned c0 = 0, c1 = 0, c2 = 0, c3 = 0; unsigned t0_, t1_, t2_, t3_;
#pragma unroll
    for (int g = 0; g < 8; ++g) { if (g * 8 < nreg) {
            IDX_CNT4(c0, c1, x[g * 8 + 0], x[g * 8 + 1], x[g * 8 + 2], x[g * 8 + 3]);
            IDX_CNT4(c2, c3, x[g * 8 + 4], x[g * 8 + 5], x[g * 8 + 6], x[g * 8 + 7]); } }
    return wave_isum((int)((c0 + c1) + (c2 + c3)));
}
__device__ __forceinline__ void load_q(const Params& P, int b, int tq, bf16x8 (&qa)[2][4], float (&wq)[2][16], int r32, int hi) {
    unsigned char* ws = P.ws; const size_t tok0 = (size_t)b * SEQ + tq * 8;
    const bf16_t* QIDX = (const bf16_t*)(ws + WS_QIDX); const float* WIDX = (const float*)(ws + WS_WIDX);
#pragma unroll
    for (int rt = 0; rt < 2; ++rt) {
        const bf16_t* qp = QIDX + (tok0 + 4 * rt + (r32 >> 3)) * 512 + (r32 & 7) * ID + 8 * hi;
#pragma unroll
        for (int d0 = 0; d0 < 4; ++d0) qa[rt][d0] = *(const bf16x8*)(qp + d0 * 16);
#pragma unroll
        for (int ql = 0; ql < 4; ++ql) { const f32x4 w4 = *(const f32x4*)(WIDX + (tok0 + 4 * rt + ql) * IH + 4 * hi);
#pragma unroll
            for (int rr = 0; rr < 4; ++rr) wq[rt][4 * ql + rr] = w4[rr]; }
    }
}
__device__ __forceinline__ void load_k0(const Params& P, int b, int tq, bf16x8 (&kn)[4], int wid, int r32, int hi) {
    const int ntile = (tq * 8 + 8 + 31) >> 5;
    if (wid < ntile) { const bf16_t* kp = (const bf16_t*)(P.ws + WS_KIDX) + (size_t)b * SEQ * ID + (size_t)wid * 2048 + hi * 256 + r32 * 8;
#pragma unroll
        for (int d0 = 0; d0 < 4; ++d0) kn[d0] = *(const bf16x8*)(kp + d0 * 512); }
}
__device__ __forceinline__ void unit(const Params& P, LAS unsigned char* lds, int b, int tq, bf16x8 (&qa)[2][4], float (&wq)[2][16], bf16x8 (&kn)[4], int bn, int tqn) {
    const int tid = threadIdx.x, lane = tid & 63, r32 = lane & 31, hi = lane >> 5; const int wid = __builtin_amdgcn_readfirstlane(tid >> 6);
    unsigned char* ws = P.ws;
    const int t0 = tq * 8; const size_t tok0 = (size_t)b * SEQ + t0;
    const bf16_t* QIDX = (const bf16_t*)(ws + WS_QIDX); const bf16_t* KIDX = (const bf16_t*)(ws + WS_KIDX) + (size_t)b * SEQ * ID; const float* WIDX = (const float*)(ws + WS_WIDX);
    LAS unsigned* sc = (LAS unsigned*)lds;
    __syncthreads();
    const int ntile = (t0 + 8 + 31) >> 5, ntile_pad = (ntile + 1) & ~1;
#ifndef REP_IDXSC
#define REP_IDXSC 1
#endif
    for (int rep_ = 0; rep_ < REP_IDXSC; ++rep_) {
    for (int kt = wid; kt < ntile_pad; kt += 8) {
        if (kt >= ntile) {
#pragma unroll
            for (int i = 0; i < 4; ++i) sc[(4 * hi + i) * SEQ + kt * 32 + r32] = 0u;
            continue; }
        bf16x8 kb[4];
#pragma unroll
        for (int d0 = 0; d0 < 4; ++d0) kb[d0] = kn[d0];
        if (kt + 8 < ntile) { const bf16_t* kp = KIDX + (size_t)(kt + 8) * 2048 + hi * 256 + r32 * 8;
#pragma unroll
            for (int d0 = 0; d0 < 4; ++d0) kn[d0] = *(const bf16x8*)(kp + d0 * 512); }
        f32x16 c0, c1;
#pragma unroll
        for (int r = 0; r < 16; ++r) { c0[r] = 0.f; c1[r] = 0.f; }
#pragma unroll
        for (int d0 = 0; d0 < 4; ++d0) { c0 = __builtin_amdgcn_mfma_f32_32x32x16_bf16(qa[0][d0], kb[d0], c0, 0, 0, 0); c1 = __builtin_amdgcn_mfma_f32_32x32x16_bf16(qa[1][d0], kb[d0], c1, 0, 0, 0); }
        float s[8];
#pragma unroll
        for (int ql = 0; ql < 4; ++ql) { float a0 = 0.f, a1 = 0.f;
#pragma unroll
            for (int rr = 0; rr < 4; ++rr) { a0 += wq[0][4 * ql + rr] * fmaxf(c0[4 * ql + rr], 0.f); a1 += wq[1][4 * ql + rr] * fmaxf(c1[4 * ql + rr], 0.f); }
            s[ql] = a0; s[4 + ql] = a1; }
        const int sk = kt * 32 + r32 - t0 - 4 * hi;
#pragma unroll
        for (int i = 0; i < 4; ++i) {
            const auto rr = __builtin_amdgcn_permlane32_swap(__builtin_bit_cast(unsigned, s[i]), __builtin_bit_cast(unsigned, s[4 + i]), false, false);
            const float v = (__builtin_bit_cast(float, (unsigned)rr[0]) + __builtin_bit_cast(float, (unsigned)rr[1])) + 0.0f;
            const unsigned u = __builtin_bit_cast(unsigned, v); const unsigned key = u ^ ((unsigned)((int)u >> 31) | 0x80000000u);
            sc[(4 * hi + i) * SEQ + kt * 32 + r32] = (sk <= i) ? key : 0u; }
    }
    }
    if (bn >= 0) { load_q(P, bn, tqn, qa, wq, r32, hi); load_k0(P, bn, tqn, kn, wid, r32, hi); }
    __syncthreads();
#ifndef REP_IDXSEL
#define REP_IDXSEL 1
#endif
    for (int rep2_ = 0; rep2_ < REP_IDXSEL; ++rep2_) {
    const int tl = t0 + wid; const int nvalid = tl + 1; const int nreg = ntile_pad >> 1;
    unsigned x[64];
#ifndef REP_SELA
#define REP_SELA 1
#define REP_SELB 1
#define REP_SELC 1
#endif
    for (int ra_ = 0; ra_ < REP_SELA; ++ra_)
    { const LAS unsigned* rowp = sc + wid * SEQ + lane;
#pragma unroll
      for (int g = 0; g < 8; ++g) {
          if (g * 8 < nreg) {
#pragma unroll
              for (int e = 0; e < 8; ++e) { const unsigned v = rowp[(g * 8 + e) * 64]; x[g * 8 + e] = (g * 8 + e < nreg) ? v : 0u; } }
          else {
#pragma unroll
              for (int e = 0; e < 8; ++e) x[g * 8 + e] = 0u; } } }
    unsigned mlo = 0u, mhi = 0u;
#define IDX_PUT(i, bal) do { const unsigned _bl = (unsigned)(bal), _bh = (unsigned)((bal) >> 32); asm volatile("s_nop 3\n\tv_writelane_b32 %0, %2, %4\n\tv_writelane_b32 %1, %3, %4" : "+v"(mlo), "+v"(mhi) : "s"(_bl), "s"(_bh), "i"(i)); } while (0)
    if (nvalid <= TOPK) {
#pragma unroll
        for (int i = 0; i < 4; ++i) { const unsigned long long bal = __ballot(x[i] != 0u); IDX_PUT(i, bal); }
    } else {
        unsigned mxk = 0u;
#pragma unroll
        for (int i = 0; i < 64; ++i) mxk = mxk > x[i] ? mxk : x[i];
        mxk = wave_umax(mxk);
        unsigned lo, hi; int c_hi; bool found; unsigned thr; float f_lo, f_hi; int last;
        for (int rb_ = 0; rb_ < REP_SELB; ++rb_) {
        lo = 1u; hi = mxk + 1u; c_hi = 0; found = false; thr = 0u; f_lo = (float)nvalid - 255.5f; f_hi = -255.5f; last = 0;
        if (mxk > 0x80000000u + (8u << 23)) { const unsigned cand = mxk - (8u << 23); const int c = count_ge(x, cand, nreg);
            if (c == TOPK) { found = true; thr = cand; } else if (c > TOPK) { lo = cand; f_lo = (float)c - 255.5f; } else { hi = cand; c_hi = c; f_hi = (float)c - 255.5f; } }
        while (!found && hi - lo > 1u) { const unsigned width = hi - lo; unsigned mid;
            if (width > (1u << 22)) mid = lo + (width >> 1);
            else { unsigned st = (unsigned)((float)width * (f_lo / (f_lo - f_hi))); st = st < 1u ? 1u : (st > width - 1u ? width - 1u : st); mid = lo + st; }
            mid = (unsigned)__builtin_amdgcn_readfirstlane((int)mid);
#ifdef PROBE_CNT2
            { int cdummy = count_ge(x, mid, nreg); asm volatile("" :: "s"(cdummy)); }
#endif
            const int c = count_ge(x, mid, nreg); const float f = (float)c - 255.5f;
            if (c == TOPK) { found = true; thr = mid; }
            else if (c > TOPK) { lo = mid; f_lo = f; if (last == 1) f_hi *= 0.5f; last = 1; }
            else { hi = mid; c_hi = c; f_hi = f; if (last == 2) f_lo *= 0.5f; last = 2; } }
        asm volatile("" : "+s"(lo), "+s"(hi) :: "memory");
        }
        for (int rc_ = 0; rc_ < REP_SELC; ++rc_)
#ifdef PROBE_K
        for (int pk_ = 0; pk_ < PROBE_K; ++pk_) { int cdummy = count_ge(x, lo + pk_, nreg); asm volatile("" :: "s"(cdummy)); }
#endif
        if (found) {
#pragma unroll
            for (int g = 0; g < 8; ++g) { if (g * 8 < nreg) {
#pragma unroll
                    for (int e = 0; e < 8; ++e) { const unsigned long long bal = __ballot(x[g * 8 + e] >= thr); IDX_PUT(g * 8 + e, bal); } } }
        } else {
            const unsigned tau = lo; const int need = TOPK - c_hi; int run = 0;
#pragma unroll
            for (int i = 0; i < 64; ++i) { const bool eq = x[i] == tau; const unsigned long long em = __ballot(eq); const int pre = run + __popcll(em & ((1ull << lane) - 1ull));
                const unsigned long long bal = __ballot(x[i] > tau || (eq && pre < need)); IDX_PUT(i, bal); run += __popcll(em); }
        }
    }
#undef IDX_PUT
    ((u32x2*)((unsigned*)(ws + WS_MASK) + (tok0 + wid) * 128))[lane] = (u32x2){mlo, mhi};
    }
}
__device__ __forceinline__ void phase(const Params& P, LAS unsigned char* lds, int vcu, int G) {
    const int lane = threadIdx.x & 63, r32 = lane & 31, hi = lane >> 5;
    bf16x8 qa[2][4], kn[4]; float wq[2][16]; const int wid = __builtin_amdgcn_readfirstlane(threadIdx.x >> 6);
#define IDX_DEC(u_, b_, tq_) const int b_ = ((u_) >> 8) >> 1, tq_ = (((u_) >> 8) & 1) ? 511 - ((u_) & 255) : ((u_) & 255)
    int u = vcu;
    if (u < T / 8) { IDX_DEC(u, b0, tq0); load_q(P, b0, tq0, qa, wq, r32, hi); load_k0(P, b0, tq0, kn, wid, r32, hi); }
    for (; u < T / 8; u += G) { IDX_DEC(u, b, tq); const int un = u + G; IDX_DEC(un, bnn, tqn); unit(P, lds, b, tq, qa, wq, kn, un < T / 8 ? bnn : -1, tqn); }
#undef IDX_DEC
    __syncthreads();
}
}
namespace dsa {
constexpr int W_STRIDE = 16384 + 640;
constexpr int L_LUT = 8 * W_STRIDE;
constexpr int L_END = L_LUT + 8192;
constexpr float NEGBIG = -1.0e30f;
typedef int v2i __attribute__((ext_vector_type(2)));
__device__ __forceinline__ int fswz(int r) { return (r < 8) ? 2 * r : 2 * ((r ^ 4) & 7) + 1; }
__device__ __forceinline__ int Fsw(int row) { return fswz(row & 15) ^ ((row >> 4) & 1); }
__device__ __forceinline__ unsigned cvtpk(float lo, float hi) { typedef __bf16 bf2 __attribute__((ext_vector_type(2))); f32x2 v = {lo, hi}; bf2 b = __builtin_convertvector(v, bf2); return __builtin_bit_cast(unsigned, b); }
__device__ __forceinline__ unsigned pk4_fp8(float a, float b, float c, float d) { int w = __builtin_amdgcn_cvt_pk_fp8_f32(a, b, 0, false); w = __builtin_amdgcn_cvt_pk_fp8_f32(c, d, w, true); return (unsigned)w; }
__device__ __forceinline__ long mk64(unsigned lo, unsigned hi) { return (long)(((unsigned long long)hi << 32) | (unsigned long long)lo); }

__device__ __forceinline__ void query(const Params& P, LAS unsigned char* wl, const LAS float* lut, const unsigned (&lcoff)[16], int b, int tl, int lane, bool dummy) {
    unsigned char* ws = P.ws;
    const int l15 = lane & 15, g = lane >> 4, q16 = lane >> 4;
    const size_t tok = (size_t)b * SEQ + tl;
    unsigned char* QL = (unsigned char*)(ws + WS_BIG) + tok * (size_t)(NH * DC);
    u32x4 srd_; (void)srd_;
    const __amdgpu_buffer_rsrc_t rsrc = __builtin_amdgcn_make_buffer_rsrc((void*)(ws + WS_CKV8 + (size_t)b * SEQ * DC), 0, SEQ * DC, 0x00020000);
    LAS unsigned short* il = (LAS unsigned short*)(wl + 16384);
    long qb[8];
#pragma unroll
    for (int p = 0; p < 4; ++p) { const u32x4 w = *(const u32x4*)(QL + l15 * DC + 64 * p + 16 * g); qb[2 * p] = mk64(w.x, w.y); qb[2 * p + 1] = mk64(w.z, w.w); }
    unsigned long long m = ((const unsigned long long*)((const unsigned*)(ws + WS_MASK) + tok * 128))[lane];
    const int cnt = __popcll(m); int inc = cnt;
#pragma unroll
    for (int o = 1; o < 64; o <<= 1) { const int v = __shfl_up(inc, o); if (lane >= o) inc += v; }
    int nsel = __builtin_amdgcn_readlane(inc, 63); nsel = nsel < TOPK ? nsel : TOPK;
    int pos = inc - cnt;
    while (m) { const int bit = __ffsll((long long)m) - 1; m &= m - 1; if (pos < TOPK) il[pos] = (unsigned short)(lane * 64 + bit); ++pos; }
    il[nsel + lane] = 0;
    asm volatile("s_waitcnt lgkmcnt(0)" ::: "memory");
    float m_run = 0.f; f32x4 o[16], lacc = (f32x4){0.f, 0.f, 0.f, 0.f};
#pragma unroll
    for (int ct = 0; ct < 16; ++ct) o[ct] = (f32x4){0.f, 0.f, 0.f, 0.f};
    const long ones = 0x3838383838383838L;
    const LAS unsigned char* abase = wl + l15 * 256;
    const int acst0 = (g ^ fswz(l15)) << 4, acst1 = acst0 ^ 16;
    const int r8 = l15 >> 1, p2 = l15 & 1; const int rowl = (r8 < 4) ? 4 * g + r8 : 16 + 4 * g + (r8 - 4);
    const LAS unsigned char* tbase = wl + rowl * 256 + 8 * p2;
    const int tcst = Fsw(rowl) << 4;
    const int nch = (nsel + 63) >> 6;
    const float b31h = lut[127 * NH + l15];
    for (int ch = 0; ch < nch; ++ch) {
        asm volatile("s_waitcnt lgkmcnt(0)" ::: "memory");
        const LAS unsigned short* ilc = il + ch * 64 + q16;
#pragma unroll
        for (int i = 0; i < 16; ++i) { const unsigned krow = ilc[4 * i];
            __builtin_amdgcn_raw_ptr_buffer_load_lds(rsrc, (LAS void*)(wl + i * 1024), 16, (krow << 8) + lcoff[i], 0, 0, 0); }
        const int kend = ch * 64 + 64; const int klast = (kend <= nsel ? kend : nsel) - 1;
        const int lastkey = __builtin_amdgcn_readfirstlane((int)il[klast]);
        const bool fast = (kend <= nsel) && (tl - lastkey >= 127);
        const float c_in = (fast ? b31h : 0.f) - m_run;
        f32x4 s[4];
#pragma unroll
        for (int t = 0; t < 4; ++t) s[t] = (f32x4){c_in, c_in, c_in, c_in};
        asm volatile("s_waitcnt vmcnt(0)" ::: "memory");
#pragma unroll
        for (int p = 0; p < 4; ++p)
#pragma unroll
            for (int t = 0; t < 4; ++t) { const u32x4 a = *(const LAS u32x4*)(abase + t * 4096 + ((p * 64) ^ ((t & 1) ? acst1 : acst0)));
                s[t] = __builtin_amdgcn_mfma_f32_16x16x32_fp8_fp8(mk64(a.x, a.y), qb[2 * p], s[t], 0, 0, 0);
                s[t] = __builtin_amdgcn_mfma_f32_16x16x32_fp8_fp8(mk64(a.z, a.w), qb[2 * p + 1], s[t], 0, 0, 0); }
        if (!fast) {
#pragma unroll
            for (int t = 0; t < 4; ++t)
#pragma unroll
                for (int e = 0; e < 4; ++e) { const int k0 = ch * 64 + 16 * t + 4 * g + e;
                    if (k0 < nsel) { const int d = tl - (int)il[k0]; s[t][e] += lut[(d < 127 ? d : 127) * NH + l15]; } else s[t][e] = NEGBIG; }
        }
        float mx = fmaxf(fmaxf(s[0][0], s[0][1]), fmaxf(s[0][2], s[0][3]));
#pragma unroll
        for (int t = 1; t < 4; ++t) mx = fmaxf(mx, fmaxf(fmaxf(s[t][0], s[t][1]), fmaxf(s[t][2], s[t][3])));
        { const auto r16 = __builtin_amdgcn_permlane16_swap(__builtin_bit_cast(unsigned, mx), __builtin_bit_cast(unsigned, mx), false, false);
          mx = fmaxf(__builtin_bit_cast(float, (unsigned)r16[0]), __builtin_bit_cast(float, (unsigned)r16[1]));
          const auto r32 = __builtin_amdgcn_permlane32_swap(__builtin_bit_cast(unsigned, mx), __builtin_bit_cast(unsigned, mx), false, false);
          mx = fmaxf(__builtin_bit_cast(float, (unsigned)r32[0]), __builtin_bit_cast(float, (unsigned)r32[1])); }
        if (ch == 0 || __any(mx > 8.0f)) {
            const float dl = (ch == 0) ? mx : fmaxf(mx, 0.f); m_run += dl;
#pragma unroll
            for (int t = 0; t < 4; ++t) s[t] = s[t] - dl;
            if (ch != 0) { const float alpha = __builtin_amdgcn_exp2f(-dl); lacc = lacc * alpha;
#pragma unroll
                for (int ct = 0; ct < 16; ++ct) o[ct] = o[ct] * alpha; }
        }
#pragma unroll
        for (int t = 0; t < 4; ++t)
#pragma unroll
            for (int e = 0; e < 4; ++e) s[t][e] = __builtin_amdgcn_exp2f(s[t][e]);
#pragma unroll
        for (int u = 0; u < 2; ++u) {
            const long pb = mk64(pk4_fp8(s[2 * u][0], s[2 * u][1], s[2 * u][2], s[2 * u][3]), pk4_fp8(s[2 * u + 1][0], s[2 * u + 1][1], s[2 * u + 1][2], s[2 * u + 1][3]));
            lacc = __builtin_amdgcn_mfma_f32_16x16x32_fp8_fp8(ones, pb, lacc, 0, 0, 0);
#pragma unroll
            for (int ct = 0; ct < 16; ++ct) { const v2i a = __builtin_amdgcn_ds_read_tr8_b64_v2i32((LAS v2i*)(tbase + u * 8192 + ((ct * 16) ^ tcst)));
                o[ct] = __builtin_amdgcn_mfma_f32_16x16x32_fp8_fp8(mk64((unsigned)a[0], (unsigned)a[1]), pb, o[ct], 0, 0, 0); }
        }
    }
    const float rl = 1.0f / lacc[0];
    unsigned char* OL = dummy ? (unsigned char*)(ws + WS_XB) + (tok & 8191) * (size_t)(NH * DC) : QL;
#pragma unroll
    for (int ct = 0; ct < 16; ++ct) { const f32x4 v = o[ct] * rl; *(unsigned*)(OL + l15 * DC + ct * 16 + 4 * g) = pk4_fp8(v[0], v[1], v[2], v[3]); }
}
__device__ __forceinline__ void phase(const Params& P, LAS unsigned char* lds, int vcu, int G) {
    const int tid = threadIdx.x, lane = tid & 63; const int wid = __builtin_amdgcn_readfirstlane(tid >> 6);
    LAS float* lut = (LAS float*)(lds + L_LUT);
    for (int i = tid; i < 128 * NH; i += NTHR) lut[i] = ((const float*)(P.ws + WS_LUT))[i];
    __syncthreads();
    LAS unsigned char* wl = lds + wid * W_STRIDE;
    unsigned lcoff[16];
#pragma unroll
    for (int i = 0; i < 16; ++i) lcoff[i] = (unsigned)(((lane & 15) ^ Fsw(4 * i + (lane >> 4))) << 4);
    const int gw = vcu * NWAVES + wid, NW = G * NWAVES;
    for (int q = gw; q < T; q += NW) { const int tl = (q >> 11) * 256 + (q & 255), b = (q >> 8) & 7;
#ifndef REP_DSA
#define REP_DSA 1
#endif
        for (int rep = 0; rep < REP_DSA; ++rep) query(P, wl, lut, lcoff, b, tl, lane, rep + 1 < REP_DSA); }
    __syncthreads();
}
}
constexpr int CW_BAR = 4096;
constexpr int MISC_OFF = LDSCTL_OFF + 64;
__device__ __forceinline__ int vcu_of(int bx, int G) { return (G % 8 == 0) ? (bx % 8) * (G / 8) + bx / 8 : bx; }

struct Args { Params P; int ph_lo, ph_hi, li, pad; };
constexpr int N_PHASES = 15;

template <int PH> __device__ __forceinline__ void gemm_ph(const Params& P, LAS unsigned char* L, int G, int bx) {
    unsigned char* ws = P.ws;
    bf16_t* XB = (bf16_t*)(ws + WS_XB); float* SSP = (float*)(ws + WS_SSP); bf16_t* BIG = (bf16_t*)(ws + WS_BIG);
    pg8::StaticOrder S;
    if constexpr (PH == 1) {
        pg8::Gemm g{XB, (const bf16_t*)(ws + WS_WQKV0), T, 3 * DM, DM / 2}; S.init(T, 3 * DM, G, bx);
        pg8::EpiQKV E{BIG, SSP, (float*)(ws + WS_KSUM)}; pg8::gemm_phase<pg8::EpiQKV, pg8::StaticOrder, true, true, true>(L, g, S, E);
    } else if constexpr (PH == 3) {
        pg8::Gemm g{(const bf16_t*)(ws + WS_O0), (const bf16_t*)(ws + WS_WO0), T, DM, DM / 2}; S.init(T, DM, G, bx);
        pg8::EpiRes<true, false> E{P.x, nullptr, XB, SSP}; pg8::gemm_phase<pg8::EpiRes<true, false>, pg8::StaticOrder, true, true, true>(L, g, S, E);
    } else if constexpr (PH == 4 || PH == 11) {
        pg8::Gemm g{XB, (const bf16_t*)(ws + (PH == 4 ? WS_WUP0 : WS_WUP1)), T, FF, DM}; S.init(T, FF, G, bx);
        pg8::EpiUp E{BIG, SSP}; pg8::gemm_phase<pg8::EpiUp, pg8::StaticOrder, true, true>(L, g, S, E);
    } else if constexpr (PH == 5 || PH == 12) {
        pg8::Gemm g{BIG, (const bf16_t*)(ws + (PH == 5 ? WS_WDN0 : WS_WDN1)), T, DM, FF}; S.init(T, DM, G, bx);
        pg8::EpiRes<false, false> E{nullptr, nullptr, XB, SSP}; pg8::gemm_phase<pg8::EpiRes<false, false>, pg8::StaticOrder, true, true>(L, g, S, E);
    } else if constexpr (PH == 6) {
        pg8::Gemm g{XB, (const bf16_t*)(ws + WS_WIN1), T, DSA_IN_PAD, DM}; S.init(T, DSA_IN_PAD, G, bx);
        pg8::EpiDsaIn E{(bf16_t*)(ws + WS_CQ), (float*)(ws + WS_CKV), (bf16_t*)(ws + WS_KIDX), (float*)(ws + WS_WIDX), (float*)(ws + WS_SSQ), SSP, (unsigned char*)(ws + WS_CQ8)};
        pg8::gemm_phase<pg8::EpiDsaIn, pg8::StaticOrder, true, true>(L, g, S, E);
    } else if constexpr (PH == 7) {
        pg8::Gemm g{(const bf16_t*)(ws + WS_CQ8), (const bf16_t*)(ws + WS_WQ1), T, NH * DC, DQ / 2}; S.init(T, NH * DC, G, bx);
        pg8::EpiDsaQ8 E{(unsigned char*)BIG, (const float*)(ws + WS_SSQ)}; pg8::gemm_phase<pg8::EpiDsaQ8, pg8::StaticOrder, true, true, true>(L, g, S, E);
    } else if constexpr (PH == 15) {
        pg8::Gemm g{(const bf16_t*)(ws + WS_CQ), (const bf16_t*)(ws + WS_WQI), T, 512, DQ}; S.init(T, 512, G, bx);
        pg8::EpiDsaQidx E{(bf16_t*)(ws + WS_QIDX), (const float*)(ws + WS_SSQ)}; pg8::gemm_phase<pg8::EpiDsaQidx, pg8::StaticOrder, true, true>(L, g, S, E);
    } else if constexpr (PH == 10) {
        pg8::Gemm g{BIG, (const bf16_t*)(ws + WS_WUVB), T, DM, DM / 2, NH * DC / 2, DM / 2}; S.init(T, DM, G, bx);
        pg8::EpiPlain8 E{(unsigned char*)(ws + WS_O0), DM}; pg8::gemm_phase<pg8::EpiPlain8, pg8::StaticOrder, true, true, true>(L, g, S, E);
    } else if constexpr (PH == 14) {
        pg8::Gemm g{(const bf16_t*)(ws + WS_O0), (const bf16_t*)(ws + WS_WO1), T, DM, DM / 2}; S.init(T, DM, G, bx);
        pg8::EpiRes<false, false> E{nullptr, nullptr, XB, SSP}; pg8::gemm_phase<pg8::EpiRes<false, false>, pg8::StaticOrder, true, true, true>(L, g, S, E);
    }
}

__global__ void __launch_bounds__(NTHR, 2) mega(Args args) {
    extern __shared__ __attribute__((aligned(16))) unsigned char lds[];
    LAS unsigned char* L = (LAS unsigned char*)lds;
    const Params& P = args.P;
    const int tid = threadIdx.x, G = gridDim.x, bx = blockIdx.x, vcu = vcu_of(bx, G);
    volatile LAS unsigned* MISC = (volatile LAS unsigned*)(L + MISC_OFF);
    for (int u = tid; u < (LDS_BYTES - LDSCTL_OFF) / 4; u += NTHR) ((LAS unsigned*)(L + LDSCTL_OFF))[u] = 0u;
    __syncthreads();
    gu32* ctl = (gu32*)(P.ws + WS_CTL);
    XcdBarrier bar = xcd_barrier_post((unsigned*)(ctl + CW_BAR) + args.li * XCD_BAR_WORDS, MISC + 8);
    const int lo = args.ph_lo, hi = args.ph_hi;
#define IN(k) (lo <= (k) && (k) < hi)
#define SEAM(k) do { if (IN(k) && IN((k) + 1)) xcd_barrier(bar); } while (0)
    const bool split_prep = (G == 256);
    if (IN(0)) { for (int rep = 0; rep < REP_PRO; ++rep) p0_prologue(P, L, vcu, G, split_prep ? 0 : 2); } SEAM(0);
    if (IN(1)) { gemm_ph<1>(P, L, G, bx); if (REP_QKV > 1) { __syncthreads(); gemm_ph<1>(P, L, G, bx); } } SEAM(1);
    if (IN(2)) { if (split_prep) p0_prologue(P, L, vcu, G, 3); for (int rep = 0; rep < REP_MOBA; ++rep) moba::phase(P, L, vcu, G); } SEAM(2);
    if (IN(3)) { gemm_ph<3>(P, L, G, bx); } SEAM(3);
    if (IN(4)) { gemm_ph<4>(P, L, G, bx); if (REP_UP0 > 1) { __syncthreads(); gemm_ph<4>(P, L, G, bx); } } SEAM(4);
    if (IN(5)) { gemm_ph<5>(P, L, G, bx); } SEAM(5);
    if (IN(6)) { gemm_ph<6>(P, L, G, bx); if (split_prep && bx >= 128) p0_prologue(P, L, bx - 128, 128, 1); } SEAM(6);
    if (IN(7)) { ckv_norm(P, vcu, G); gemm_ph<7>(P, L, G, bx); gemm_ph<15>(P, L, G, bx);
#ifdef REP_QPROJ
        __syncthreads(); gemm_ph<7>(P, L, G, bx);
#endif
    } SEAM(7);
    if (IN(8)) { for (int rep = 0; rep < REP_IDX; ++rep) idx::phase(P, L, vcu, G); } SEAM(8);
    if (IN(9)) { dsa::phase(P, L, vcu, G); } SEAM(9);
    if (IN(10)) { gemm_ph<10>(P, L, G, bx); } SEAM(10);
    if (IN(11)) { gemm_ph<14>(P, L, G, bx); } SEAM(11);
    if (IN(12)) { gemm_ph<11>(P, L, G, bx); } SEAM(12);
    if (IN(13)) { gemm_ph<12>(P, L, G, bx); } SEAM(13);
    if (IN(14)) { final_norm(P, vcu, G); }
#undef IN
#undef SEAM
}

extern "C" void kernel_launch(void* const* d_in, const int* in_sizes, int n_in, void* d_out, int out_size, void* d_ws, size_t ws_size, hipStream_t stream) {
    static int grid = 0;
    if (grid == 0) {
        if (n_in != 17 || in_sizes[0] != T * DM || out_size != T * DM || ws_size < WS_END) { fprintf(stderr, "kernel_launch: unexpected shapes (n_in %d, in0 %d, out %d, ws %zu)\n", n_in, n_in > 0 ? in_sizes[0] : -1, out_size, ws_size); grid = -1; return; }
        int dev = 0, cus = 0;
        if (hipGetDevice(&dev) != hipSuccess || hipDeviceGetAttribute(&cus, hipDeviceAttributeMultiprocessorCount, dev) != hipSuccess) { grid = -1; return; }
        if (hipFuncSetAttribute((const void*)mega, hipFuncAttributeMaxDynamicSharedMemorySize, LDS_BYTES) != hipSuccess) { fprintf(stderr, "kernel_launch: hipFuncSetAttribute failed\n"); grid = -1; return; }
        (void)hipGetLastError();
        grid = cus;
    }
    if (grid < 0) return;
    if (hipMemsetAsync((char*)d_ws + WS_CTL, 0, CTL_ZERO_BYTES, stream) != hipSuccess) return;
    Args a{};
    Params& P = a.P;
    P.x = (const float*)d_in[0]; P.rel_bias = (const float*)d_in[1]; P.ln_attn = (const float*)d_in[2]; P.ln_mlp = (const float*)d_in[3]; P.moba_w_qkv = (const float*)d_in[4]; P.moba_w_o = (const float*)d_in[5];
    P.dsa_w_in = (const float*)d_in[6]; P.dsa_g_q = (const float*)d_in[7]; P.dsa_g_kv = (const float*)d_in[8]; P.dsa_w_uq = (const float*)d_in[9]; P.dsa_w_qi = (const float*)d_in[10]; P.dsa_w_uk = (const float*)d_in[11];
    P.dsa_w_uv = (const float*)d_in[12]; P.dsa_w_o = (const float*)d_in[13]; P.mlp_w_up = (const float*)d_in[14]; P.mlp_w_down = (const float*)d_in[15]; P.final_norm = (const float*)d_in[16];
    P.out = (float*)d_out; P.ws = (unsigned char*)d_ws;
    const dim3 g(grid), b(NTHR);
    a.ph_lo = 0; a.ph_hi = 15; a.li = 0; hipLaunchKernelGGL(mega, g, b, LDS_BYTES, stream, a);
}
```

```cpp
#include <hip/hip_runtime.h>
#include <cstdio>
#include <cstdint>
#ifndef REP_PRO
#define REP_PRO 1
#endif
#ifndef REP_QKV
#define REP_QKV 1
#endif
#ifndef REP_MOBA
#define REP_MOBA 1
#endif
#ifndef REP_UP0
#define REP_UP0 1
#endif
#ifndef REP_IDX
#define REP_IDX 1
#endif

constexpr int NB = 8, SEQ = 4096, DM = 1024, NH = 16, HD = 64, FF = 4096;
constexpr int T = NB * SEQ;
constexpr int MBLK = 256, NBLK = SEQ / MBLK;
constexpr int DQ = 256, DC = 256, IH = 8, ID = 64;
constexpr int DSA_IN = DQ + DC + ID + IH;
constexpr int DSA_IN_PAD = 768;
constexpr int TOPK = 256;
constexpr float EPS = 1e-6f;
constexpr float LOG2E = 1.4426950408889634f;
constexpr float C2 = 0.125f * LOG2E;

constexpr size_t MiB = 1u << 20;
constexpr size_t WS_CTL = 0, CTL_ZERO_BYTES = 1 * MiB;
constexpr size_t WS_WQKV0 = 1 * MiB, WS_WO0 = 7 * MiB, WS_WUP0 = 9 * MiB, WS_WDN0 = 17 * MiB, WS_WIN1 = 25 * MiB, WS_WQ1 = 27 * MiB,
                 WS_WUVB = 30 * MiB, WS_WO1 = 32 * MiB, WS_WUP1 = 38 * MiB, WS_WDN1 = 46 * MiB;
constexpr size_t WS_SSP = 54 * MiB;
constexpr size_t WS_KSUM = 56 * MiB;
constexpr size_t WS_LUT = 57 * MiB;
constexpr size_t WS_XB = 58 * MiB;
constexpr size_t WS_CQ = 122 * MiB;
constexpr size_t WS_CKVN = 138 * MiB;
constexpr size_t WS_CKV8 = 138 * MiB;
constexpr size_t WS_CQ8 = 146 * MiB;
constexpr size_t WS_WQI = 28 * MiB;
constexpr size_t WS_KIDX = 154 * MiB;
constexpr size_t WS_WIDX = 158 * MiB;
constexpr size_t WS_SSQ = 159 * MiB;
constexpr size_t WS_O0 = 160 * MiB;
constexpr size_t WS_QIDX = 160 * MiB;
constexpr size_t WS_MASK = 192 * MiB;
constexpr size_t WS_CKV = 208 * MiB;
constexpr size_t WS_BIG = 240 * MiB;
constexpr size_t WS_END = 496 * MiB;

typedef unsigned short bf16_t;
typedef float f32x4 __attribute__((ext_vector_type(4)));
typedef float f32x2 __attribute__((ext_vector_type(2)));
typedef unsigned u32x4 __attribute__((ext_vector_type(4)));
typedef unsigned u32x2 __attribute__((ext_vector_type(2)));
typedef short bf16x8 __attribute__((ext_vector_type(8)));
#define GAS __attribute__((address_space(1)))
#define LAS __attribute__((address_space(3)))

__device__ __forceinline__ unsigned f2bf(float f) { unsigned u = __builtin_bit_cast(unsigned, f); return (u + 0x7fffu + ((u >> 16) & 1u)) >> 16; }
__device__ __forceinline__ unsigned pk2(float lo, float hi) { return f2bf(lo) | (f2bf(hi) << 16); }
__device__ __forceinline__ float bf2f(unsigned h) { return __builtin_bit_cast(float, h << 16); }
__device__ __forceinline__ float bflo(unsigned w) { return __builtin_bit_cast(float, w << 16); }
__device__ __forceinline__ float bfhi(unsigned w) { return __builtin_bit_cast(float, w & 0xffff0000u); }

__device__ const unsigned char BUCKET_TAB[128] = {0,1,2,3,4,5,6,7,8,9,10,11,12,13,14,15,16,16,16,17,17,18,18,18,19,19,19,20,20,20,20,21,21,21,21,22,22,22,22,22,23,23,23,23,23,23,24,24,24,24,24,24,25,25,25,25,25,25,25,26,26,26,26,26,26,26,26,27,27,27,27,27,27,27,27,27,27,28,28,28,28,28,28,28,28,28,28,29,29,29,29,29,29,29,29,29,29,29,29,30,30,30,30,30,30,30,30,30,30,30,30,30,30,31,31,31,31,31,31,31,31,31,31,31,31,31,31,31};

__device__ __forceinline__ float sumsq4(const f32x4 a) { return (a[0] * a[0] + a[1] * a[1]) + (a[2] * a[2] + a[3] * a[3]); }

namespace pg8 {
#define PG8_LAS __attribute__((address_space(3)))
typedef unsigned short bf16_t;
typedef short bf16x8 __attribute__((ext_vector_type(8)));
typedef float f32x4 __attribute__((ext_vector_type(4)));
typedef unsigned u32x4 __attribute__((ext_vector_type(4)));
constexpr int BM = 256, BK = 64, HALF = 128, HTB = HALF * BK * 2  , STAGE_BYTES = 8 * HTB, NXCD = 8, WGM = 8;

__host__ __device__ __forceinline__ int lds_byte(int r, int c) { const int st = (r >> 4) * 2 + (c >> 5), rr = r & 15, cc = c & 31, ob = rr * 64 + cc * 2; return st * 1024 + (ob ^ (((ob >> 9) & 1) << 5)); }
__host__ __device__ __forceinline__ void stage_rc(int b, int& R, int& C) { const int st = b / 1024, sb = b % 1024, swz = sb ^ (((sb >> 9) & 1) << 5); R = (st >> 1) * 16 + swz / 64; C = (st & 1) * 32 + (swz % 64) / 2; }
__host__ __device__ __forceinline__ int perm32(int rho) { const int n = rho >> 4, i = rho & 15; return 8 * (i >> 2) + 4 * n + (i & 3); }

struct Unit { int pm, pn; };
struct Gemm { const bf16_t* A; const bf16_t* Bt; int M, N, K; int lda = 0, a_pn_off = 0; };

struct StaticOrder {
    int nM, nN, nwg, G, c;
    __host__ __device__ void init(int M, int N, int G_, int c_) { nM = M / BM; nN = N / BM; nwg = nM * nN; G = G_; c = c_; }
    __host__ __device__ bool next(int i, Unit& u) const {
        const long L = (long)i * G + c; if (L >= nwg) return false;
        int wgid = (int)L; { const int q = nwg / NXCD, r = nwg % NXCD, xcd = wgid % NXCD, off = wgid / NXCD; wgid = (xcd < r ? xcd * (q + 1) : r * (q + 1) + (xcd - r) * q) + off; }
        const int nig = WGM * nN, gid = wgid / nig, fm = gid * WGM, gsz = (nM - fm) < WGM ? (nM - fm) : WGM;
        u.pm = fm + ((wgid % nig) % gsz); u.pn = (wgid % nig) / gsz; return true;
    }
    __device__ __forceinline__ void a_ready(const Unit&) const {}
    __device__ __forceinline__ void done(const Unit&) const {}
};


__device__ __forceinline__ unsigned cvt_pk_bf16(float lo, float hi) { unsigned r; asm volatile("v_cvt_pk_bf16_f32 %0, %1, %2" : "=v"(r) : "v"(lo), "v"(hi)); return r; }
__device__ __forceinline__ u32x4 pack8(const f32x4 a, const f32x4 b) { u32x4 w; w.x = cvt_pk_bf16(a[0], a[1]); w.y = cvt_pk_bf16(a[2], a[3]); w.z = cvt_pk_bf16(b[0], b[1]); w.w = cvt_pk_bf16(b[2], b[3]); return w; }
__device__ __forceinline__ u32x2 pack8_fp8(const f32x4 a, const f32x4 b) { u32x2 w; int t = __builtin_amdgcn_cvt_pk_fp8_f32(a[0], a[1], 0, false); t = __builtin_amdgcn_cvt_pk_fp8_f32(a[2], a[3], t, true); w.x = (unsigned)t;
    t = __builtin_amdgcn_cvt_pk_fp8_f32(b[0], b[1], 0, false); t = __builtin_amdgcn_cvt_pk_fp8_f32(b[2], b[3], t, true); w.y = (unsigned)t; return w; }
__device__ __forceinline__ float row_rstd16(const float* ssp, int row) {
    const f32x4* p = (const f32x4*)(ssp + (size_t)row * 16); const f32x4 a = p[0], b = p[1], c = p[2], d = p[3];
    const float s = ((a[0] + a[1]) + (a[2] + a[3])) + ((b[0] + b[1]) + (b[2] + b[3])) + ((c[0] + c[1]) + (c[2] + c[3])) + ((d[0] + d[1]) + (d[2] + d[3]));
    return 1.0f / sqrtf(s * (1.0f / 1024.0f) + EPS);
}

__device__ __forceinline__ float row_rstd16_q(const float* ssp, int row, int fq) {
    const f32x4 a = *(const f32x4*)(ssp + (size_t)row * 16 + 4 * fq); float s = (a[0] + a[1]) + (a[2] + a[3]);
    s += __shfl_xor(s, 16); s += __shfl_xor(s, 32);
    return 1.0f / sqrtf(s * (1.0f / 1024.0f) + EPS);
}

struct EpiQKV {
    static constexpr bool PERM = true, AFTER_DRAIN = false;
    bf16_t* Q; const float* ssp; float* ksum;
    __device__ __forceinline__ void operator()(const f32x4 (&acc)[2][2][4][2], const Unit& u, int wr, int wc, int fr, int fq) const {
        const int row0 = u.pm * BM + wr * 64 + fr; int colt = u.pn * BM; const int t = colt >> 10; colt &= 1023;
        unsigned char* base = (unsigned char*)Q + (size_t)t * T * DM; const float sc = (t == 0) ? C2 * 8.0f : 1.0f;
        const int col0 = colt + wc * 32 + 8 * fq;
        f32x4 cs[2][2];
#pragma unroll
        for (int bj = 0; bj < 2; ++bj)
#pragma unroll
            for (int n = 0; n < 2; ++n) cs[bj][n] = (f32x4){0.f, 0.f, 0.f, 0.f};
#pragma unroll
        for (int ai = 0; ai < 2; ++ai)
#pragma unroll
            for (int m = 0; m < 4; ++m) { const int row = row0 + ai * HALF + m * 16; const float rs = row_rstd16_q(ssp, row, fq) * sc; unsigned char* rowp = base + (size_t)row * DM + col0;
#pragma unroll
                for (int bj = 0; bj < 2; ++bj) { const f32x4 v0 = acc[ai][bj][m][0] * rs, v1 = acc[ai][bj][m][1] * rs; cs[bj][0] += v0; cs[bj][1] += v1;
                    *(u32x2*)(rowp + bj * HALF) = pack8_fp8(v0, v1); } }
        if (t == 1) {
#pragma unroll
            for (int bj = 0; bj < 2; ++bj)
#pragma unroll
                for (int n = 0; n < 2; ++n) { f32x4 s = cs[bj][n];
#pragma unroll
                    for (int o = 1; o < 16; o <<= 1) { s[0] += __shfl_xor(s[0], o); s[1] += __shfl_xor(s[1], o); s[2] += __shfl_xor(s[2], o); s[3] += __shfl_xor(s[3], o); }
                    if (fr == 0) *(f32x4*)(ksum + ((size_t)(u.pm * 2 + wr)) * DM + col0 + bj * HALF + 4 * n) = s; }
        }
    }
};
template <bool BASE32, bool OUT32> struct EpiRes {
    static constexpr bool PERM = true, AFTER_DRAIN = false;
    const float* base32; float* X; bf16_t* XB; float* ssp;
    __device__ __forceinline__ void operator()(const f32x4 (&acc)[2][2][4][2], const Unit& u, int wr, int wc, int fr, int fq) const {
        const int row0 = u.pm * BM + wr * 64 + fr; const int col0 = u.pn * BM + wc * 32 + 8 * fq;
#pragma unroll
        for (int ai = 0; ai < 2; ++ai)
#pragma unroll
            for (int m = 0; m < 4; ++m) { const int row = row0 + ai * HALF + m * 16; const size_t off = (size_t)row * DM + col0; float ss = 0.f;
#pragma unroll
                for (int bj = 0; bj < 2; ++bj) { f32x4 b0, b1;
                    if constexpr (BASE32) { b0 = *(const f32x4*)(base32 + off + bj * HALF); b1 = *(const f32x4*)(base32 + off + bj * HALF + 4); }
                    else { const u32x4 w = *(const u32x4*)(XB + off + bj * HALF); b0 = (f32x4){bflo(w.x), bfhi(w.x), bflo(w.y), bfhi(w.y)}; b1 = (f32x4){bflo(w.z), bfhi(w.z), bflo(w.w), bfhi(w.w)}; }
                    const f32x4 v0 = b0 + acc[ai][bj][m][0], v1 = b1 + acc[ai][bj][m][1];
                    if constexpr (OUT32) { *(f32x4*)(X + off + bj * HALF) = v0; *(f32x4*)(X + off + bj * HALF + 4) = v1; }
                    else *(u32x4*)(XB + off + bj * HALF) = pack8(v0, v1);
                    ss += sumsq4(v0) + sumsq4(v1); }
                ss += __shfl_xor(ss, 16); ss += __shfl_xor(ss, 32);
                if (fq == 0) ssp[(size_t)row * 16 + u.pn * 4 + wc] = ss; }
    }
};
template <bool OUT8> struct EpiUp {
    static constexpr bool PERM = true, AFTER_DRAIN = false;
    bf16_t* U; const float* ssp;
    __device__ __forceinline__ void operator()(const f32x4 (&acc)[2][2][4][2], const Unit& u, int wr, int wc, int fr, int fq) const {
        const int row0 = u.pm * BM + wr * 64 + fr; const int col0 = u.pn * BM + wc * 32 + 8 * fq;
#pragma unroll
        for (int ai = 0; ai < 2; ++ai)
#pragma unroll
            for (int m = 0; m < 4; ++m) { const int row = row0 + ai * HALF + m * 16; const float rs = row_rstd16_q(ssp, row, fq); bf16_t* rowp = U + (size_t)row * FF + col0;
#pragma unroll
                for (int bj = 0; bj < 2; ++bj) { f32x4 v0 = acc[ai][bj][m][0] * rs, v1 = acc[ai][bj][m][1] * rs;
                    v0 = __builtin_elementwise_max(v0, (f32x4){0.f, 0.f, 0.f, 0.f}); v1 = __builtin_elementwise_max(v1, (f32x4){0.f, 0.f, 0.f, 0.f}); v0 = v0 * v0; v1 = v1 * v1;
                    if constexpr (OUT8) *(u32x2*)((unsigned char*)U + (size_t)row * FF + col0 + bj * HALF) = pack8_fp8(v0, v1);
                    else *(u32x4*)(rowp + bj * HALF) = pack8(v0, v1); } }
    }
};
struct EpiDsaIn {
    static constexpr bool PERM = true, AFTER_DRAIN = false;
    bf16_t* CQ; float* CKV; bf16_t* KIDX; float* WIDX; float* ssq; const float* ssp; unsigned char* CQ8;
    __device__ __forceinline__ void operator()(const f32x4 (&acc)[2][2][4][2], const Unit& u, int wr, int wc, int fr, int fq) const {
        const int row0 = u.pm * BM + wr * 64 + fr; const int c0 = wc * 32 + 8 * fq;
#pragma unroll
        for (int ai = 0; ai < 2; ++ai)
#pragma unroll
            for (int m = 0; m < 4; ++m) { const int row = row0 + ai * HALF + m * 16; const float rs = row_rstd16_q(ssp, row, fq);
                f32x4 v[2][2];
#pragma unroll
                for (int bj = 0; bj < 2; ++bj) { v[bj][0] = acc[ai][bj][m][0] * rs; v[bj][1] = acc[ai][bj][m][1] * rs; }
                if (u.pn < 2) {
                    float ss = (sumsq4(v[0][0]) + sumsq4(v[0][1])) + (sumsq4(v[1][0]) + sumsq4(v[1][1]));
                    ss += __shfl_xor(ss, 16); ss += __shfl_xor(ss, 32);
                    if (fq == 0) ssq[(size_t)row * 8 + u.pn * 4 + wc] = ss;
                    if (u.pn == 0) {
#pragma unroll
                        for (int bj = 0; bj < 2; ++bj) { *(u32x4*)(CQ + (size_t)row * DQ + c0 + bj * HALF) = pack8(v[bj][0], v[bj][1]); *(u32x2*)(CQ8 + (size_t)row * DQ + c0 + bj * HALF) = pack8_fp8(v[bj][0], v[bj][1]); }
                    } else {
#pragma unroll
                        for (int bj = 0; bj < 2; ++bj) { *(f32x4*)(CKV + (size_t)row * DC + c0 + bj * HALF) = v[bj][0]; *(f32x4*)(CKV + (size_t)row * DC + c0 + bj * HALF + 4) = v[bj][1]; }
                    }
                } else {
                    if (wc < 2) *(u32x4*)(KIDX + (size_t)(row >> 5) * 2048 + (c0 >> 3) * 256 + (row & 31) * 8) = pack8(v[0][0], v[0][1]);
                    else if (wc == 2 && fq == 0) { const float ws = 0.04419417382415922f;
                        *(f32x4*)(WIDX + (size_t)row * IH) = v[0][0] * ws; *(f32x4*)(WIDX + (size_t)row * IH + 4) = v[0][1] * ws; }
                }
            }
    }
};
struct EpiDsaQ8 {
    static constexpr bool PERM = true, AFTER_DRAIN = false;
    unsigned char* QLAT8; const float* ssq;
    __device__ __forceinline__ void operator()(const f32x4 (&acc)[2][2][4][2], const Unit& u, int wr, int wc, int fr, int fq) const {
        const int row0 = u.pm * BM + wr * 64 + fr; const int col0 = u.pn * BM + wc * 32 + 8 * fq;
#pragma unroll
        for (int ai = 0; ai < 2; ++ai)
#pragma unroll
            for (int m = 0; m < 4; ++m) { const int row = row0 + ai * HALF + m * 16; const f32x4 p = *(const f32x4*)(ssq + (size_t)row * 8);
                const float rs = 1.0f / sqrtf(((p[0] + p[1]) + (p[2] + p[3])) * (1.0f / 256.0f) + EPS); unsigned char* rowp = QLAT8 + (size_t)row * (NH * DC) + col0;
#pragma unroll
                for (int bj = 0; bj < 2; ++bj) *(u32x2*)(rowp + bj * HALF) = pack8_fp8(acc[ai][bj][m][0] * rs, acc[ai][bj][m][1] * rs); }
    }
};
struct EpiDsaQidx {
    static constexpr bool PERM = true, AFTER_DRAIN = false;
    bf16_t* QIDX; const float* ssq;
    __device__ __forceinline__ void operator()(const f32x4 (&acc)[2][2][4][2], const Unit& u, int wr, int wc, int fr, int fq) const {
        const int row0 = u.pm * BM + wr * 64 + fr; const int col0 = u.pn * BM + wc * 32 + 8 * fq;
#pragma unroll
        for (int ai = 0; ai < 2; ++ai)
#pragma unroll
            for (int m = 0; m < 4; ++m) { const int row = row0 + ai * HALF + m * 16; const f32x4 p = *(const f32x4*)(ssq + (size_t)row * 8);
                const float rs = 1.0f / sqrtf(((p[0] + p[1]) + (p[2] + p[3])) * (1.0f / 256.0f) + EPS); bf16_t* rowp = QIDX + (size_t)row * 512 + col0;
#pragma unroll
                for (int bj = 0; bj < 2; ++bj) *(u32x4*)(rowp + bj * HALF) = pack8(acc[ai][bj][m][0] * rs, acc[ai][bj][m][1] * rs); }
    }
};
struct EpiPlain {
    static constexpr bool PERM = true, AFTER_DRAIN = false;
    bf16_t* O; int ldc;
    __device__ __forceinline__ void operator()(const f32x4 (&acc)[2][2][4][2], const Unit& u, int wr, int wc, int fr, int fq) const {
        const int row0 = u.pm * BM + wr * 64 + fr; const int col0 = u.pn * BM + wc * 32 + 8 * fq;
#pragma unroll
        for (int ai = 0; ai < 2; ++ai)
#pragma unroll
            for (int m = 0; m < 4; ++m) { bf16_t* rowp = O + (size_t)(row0 + ai * HALF + m * 16) * ldc + col0;
#pragma unroll
                for (int bj = 0; bj < 2; ++bj) *(u32x4*)(rowp + bj * HALF) = pack8(acc[ai][bj][m][0], acc[ai][bj][m][1]); }
    }
};

struct EpiPlain8 {
    static constexpr bool PERM = true, AFTER_DRAIN = false;
    unsigned char* O; int ldc;
    __device__ __forceinline__ void operator()(const f32x4 (&acc)[2][2][4][2], const Unit& u, int wr, int wc, int fr, int fq) const {
        const int row0 = u.pm * BM + wr * 64 + fr; const int col0 = u.pn * BM + wc * 32 + 8 * fq;
#pragma unroll
        for (int ai = 0; ai < 2; ++ai)
#pragma unroll
            for (int m = 0; m < 4; ++m) { unsigned char* rowp = O + (size_t)(row0 + ai * HALF + m * 16) * ldc + col0;
#pragma unroll
                for (int bj = 0; bj < 2; ++bj) *(u32x2*)(rowp + bj * HALF) = pack8_fp8(acc[ai][bj][m][0], acc[ai][bj][m][1]); }
    }
};

template <class Epi, class Sched, bool ALIGN_EPI = false, bool SP2 = false, bool FP8 = false>
__device__ __forceinline__ void gemm_phase(PG8_LAS unsigned char* lds, const Gemm g, const Sched& S, const Epi& E) {
    const int tid = threadIdx.x, wid = __builtin_amdgcn_readfirstlane(tid >> 6), lane = tid & 63, wr = wid >> 2, wc = wid & 3, fr = lane & 15, fq = lane >> 4;
    const int K = g.K, nt = K / BK; const int lda = g.lda ? g.lda : K;
    unsigned voffA[2], voffB[2];
#pragma unroll
    for (int i = 0; i < 2; ++i) { int R, C; stage_rc(tid * 16 + i * 8192, R, C); const int Rb = Epi::PERM ? ((R & ~31) + perm32(R & 31)) : R;
        voffA[i] = (unsigned)(R * lda + C) * 2u; voffB[i] = (unsigned)(Rb * K + C) * 2u; }
    const size_t kstep = (size_t)(BK * 2);
    const size_t hstep = (size_t)HALF * K * 2;
    const size_t tstep = 2 * hstep;
    const size_t hstepA = (size_t)HALF * lda * 2, tstepA = 2 * hstepA, pnoffA = (size_t)g.a_pn_off * 2;
    const unsigned ldsw = (unsigned)wid * 1024u;
    const int aoff = lds_byte(wr * 64 + fr, fq * 8), boff = lds_byte(wc * 32 + fr, fq * 8);
#define PG8_SA(b, h) (((b) * 2 + (h)) * HTB)
#define PG8_SB(b, h) ((4 + (b) * 2 + (h)) * HTB)
#define PG8_STAGE(bufoff, gbase, voff) do { _Pragma("unroll") for (int _i = 0; _i < 2; ++_i) \
        __builtin_amdgcn_global_load_lds((const unsigned*)((const char*)(gbase) + (voff)[_i]), (PG8_LAS unsigned*)(lds + (bufoff) + ldsw + _i * 8192), 16, 0, 0); } while (0)
#define PG8_LDA(dst, b, h) do { if constexpr (FP8) { _Pragma("unroll") for (int m = 0; m < 4; ++m) { const v4i_ _lo = *(const PG8_LAS v4i_*)(lds + PG8_SA(b, h) + aoff + m * 2048), _hi = *(const PG8_LAS v4i_*)(lds + PG8_SA(b, h) + aoff + m * 2048 + 1024); dst##8[m] = __builtin_shufflevector(_lo, _hi, 0, 1, 2, 3, 4, 5, 6, 7); } } \
        else { _Pragma("unroll") for (int m = 0; m < 4; ++m) _Pragma("unroll") for (int k = 0; k < 2; ++k) dst[m][k] = *(const PG8_LAS bf16x8*)(lds + PG8_SA(b, h) + aoff + m * 2048 + k * 1024); } } while (0)
#define PG8_LDB(dst, b, h) do { if constexpr (FP8) { _Pragma("unroll") for (int n = 0; n < 2; ++n) { const v4i_ _lo = *(const PG8_LAS v4i_*)(lds + PG8_SB(b, h) + boff + n * 2048), _hi = *(const PG8_LAS v4i_*)(lds + PG8_SB(b, h) + boff + n * 2048 + 1024); dst##8[n] = __builtin_shufflevector(_lo, _hi, 0, 1, 2, 3, 4, 5, 6, 7); } } \
        else { _Pragma("unroll") for (int n = 0; n < 2; ++n) _Pragma("unroll") for (int k = 0; k < 2; ++k) dst[n][k] = *(const PG8_LAS bf16x8*)(lds + PG8_SB(b, h) + boff + n * 2048 + k * 1024); } } while (0)
#define PG8_MMA(ai, bj, At, Bt) do { __builtin_amdgcn_s_setprio(1); _Pragma("unroll") for (int m = 0; m < 4; ++m) _Pragma("unroll") for (int n = 0; n < 2; ++n) { \
        if constexpr (FP8) asm volatile("v_mfma_scale_f32_16x16x128_f8f6f4 %0, %1, %2, %0, %3, %4 op_sel_hi:[0,0,0]" : "+v"(acc[ai][bj][m][n]) : "v"(Bt##8[n]), "v"(At##8[m]), "v"(sclW), "v"(sclX)); \
        else { _Pragma("unroll") for (int k = 0; k < 2; ++k) acc[ai][bj][m][n] = __builtin_amdgcn_mfma_f32_16x16x32_bf16(Bt[n][k], At[m][k], acc[ai][bj][m][n], 0, 0, 0); } } \
        __builtin_amdgcn_s_setprio(0); } while (0)
#define PG8_WAIT_V(n) asm volatile("s_waitcnt vmcnt(" #n ")" ::: "memory")
#define PG8_WAIT_L(n) asm volatile("s_waitcnt lgkmcnt(" #n ")" ::: "memory")
#define PG8_BAR __builtin_amdgcn_s_barrier()
#define PG8_SCHED __builtin_amdgcn_sched_barrier(0)
    Unit cur, nxt; int ui = 0;
    if (!S.next(0, cur)) return;
    f32x4 acc[2][2][4][2];
#pragma unroll
    for (int a = 0; a < 2; ++a)
#pragma unroll
        for (int b = 0; b < 2; ++b)
#pragma unroll
            for (int m = 0; m < 4; ++m)
#pragma unroll
                for (int n = 0; n < 2; ++n) acc[a][b][m][n] = (f32x4){0.f, 0.f, 0.f, 0.f};
    typedef int v4i_ __attribute__((ext_vector_type(4))); typedef int v8i_ __attribute__((ext_vector_type(8)));
    const int sclW = 0x7B7B7B7B, sclX = 0x7F7F7F7F;
    bf16x8 At[4][2], B0[2][2], B1[2][2]; v8i_ At8[4], B08[2], B18[2];
    const char* cA = (const char*)g.A + (size_t)cur.pm * tstepA + (size_t)cur.pn * pnoffA; const char* cB = (const char*)g.Bt + (size_t)cur.pn * tstep;
    S.a_ready(cur);
    if constexpr (SP2) {
        PG8_STAGE(PG8_SB(0, 0), cB, voffB); PG8_STAGE(PG8_SB(0, 1), cB + hstep, voffB); PG8_STAGE(PG8_SA(0, 0), cA, voffA); PG8_STAGE(PG8_SA(0, 1), cA + hstepA, voffA);
        if (wr == 1) PG8_BAR;
        PG8_WAIT_V(2); PG8_BAR;
        PG8_STAGE(PG8_SB(1, 0), cB + kstep, voffB); PG8_STAGE(PG8_SA(1, 0), cA + kstep, voffA); PG8_STAGE(PG8_SB(1, 1), cB + hstep + kstep, voffB);
        PG8_WAIT_V(6); PG8_BAR;
    } else {
        PG8_STAGE(PG8_SB(0, 0), cB, voffB); PG8_STAGE(PG8_SA(0, 0), cA, voffA); PG8_STAGE(PG8_SB(0, 1), cB + hstep, voffB); PG8_STAGE(PG8_SA(0, 1), cA + hstepA, voffA);
        if (wr == 1) PG8_BAR;
        PG8_WAIT_V(4); PG8_BAR;
        PG8_STAGE(PG8_SB(1, 0), cB + kstep, voffB); PG8_STAGE(PG8_SA(1, 0), cA + kstep, voffA); PG8_STAGE(PG8_SB(1, 1), cB + hstep + kstep, voffB);
        PG8_WAIT_V(6); PG8_BAR;
    }
    for (;;) {
        const bool has_next = S.next(ui + 1, nxt);
        const char* nA = has_next ? (const char*)g.A + (size_t)nxt.pm * tstepA + (size_t)nxt.pn * pnoffA : cA; const char* nB = has_next ? (const char*)g.Bt + (size_t)nxt.pn * tstep : cB;
#pragma nounroll
        for (int t = 0; t < nt; t += 2) {
            const bool last = (t == nt - 2);
            const char* a1 = cA + (size_t)(t + 1) * kstep;
            const char* a2 = last ? nA : cA + (size_t)(t + 2) * kstep; const char* b2 = last ? nB : cB + (size_t)(t + 2) * kstep;
            const char* a3 = a2 + kstep; const char* b3 = b2 + kstep;
            if (last && has_next) S.a_ready(nxt);
            if constexpr (SP2) {
            PG8_LDB(B0, 0, 0); PG8_LDB(B1, 0, 1); PG8_SCHED; PG8_LDA(At, 0, 0); PG8_STAGE(PG8_SA(1, 1), a1 + hstepA, voffA);
            PG8_WAIT_V(8); PG8_WAIT_L(0); PG8_BAR; PG8_MMA(0, 0, At, B0); PG8_MMA(0, 1, At, B1); PG8_BAR; PG8_SCHED;
            PG8_LDA(At, 0, 1); PG8_STAGE(PG8_SB(0, 0), b2, voffB); PG8_STAGE(PG8_SB(0, 1), b2 + hstep, voffB); PG8_STAGE(PG8_SA(0, 0), a2, voffA);
            PG8_WAIT_V(8); PG8_WAIT_L(0); PG8_BAR; PG8_MMA(1, 0, At, B0); PG8_MMA(1, 1, At, B1); PG8_BAR; PG8_SCHED;
            PG8_LDB(B0, 1, 0); PG8_LDB(B1, 1, 1); PG8_SCHED; PG8_LDA(At, 1, 0); PG8_STAGE(PG8_SA(0, 1), a2 + hstepA, voffA);
            PG8_WAIT_V(8); PG8_WAIT_L(0); PG8_BAR; PG8_MMA(0, 0, At, B0); PG8_MMA(0, 1, At, B1); PG8_BAR; PG8_SCHED;
            PG8_LDA(At, 1, 1); PG8_STAGE(PG8_SB(1, 0), b3, voffB); PG8_STAGE(PG8_SB(1, 1), b3 + hstep, voffB); PG8_STAGE(PG8_SA(1, 0), a3, voffA);
            PG8_WAIT_V(8); PG8_WAIT_L(0); PG8_BAR; PG8_MMA(1, 0, At, B0); PG8_MMA(1, 1, At, B1); PG8_BAR; PG8_SCHED;
            } else {
            PG8_LDB(B0, 0, 0); PG8_SCHED; PG8_LDA(At, 0, 0); PG8_STAGE(PG8_SA(1, 1), a1 + hstepA, voffA);
            PG8_WAIT_L(8); PG8_BAR; PG8_WAIT_L(0); PG8_MMA(0, 0, At, B0); PG8_BAR; PG8_SCHED;
            PG8_LDB(B1, 0, 1); PG8_STAGE(PG8_SB(0, 0), b2, voffB);
            PG8_BAR; PG8_WAIT_L(0); PG8_MMA(0, 1, At, B1); PG8_BAR;
            PG8_LDA(At, 0, 1); PG8_STAGE(PG8_SA(0, 0), a2, voffA);
            PG8_BAR; PG8_WAIT_L(0); PG8_MMA(1, 0, At, B0); PG8_BAR; PG8_SCHED;
            PG8_STAGE(PG8_SB(0, 1), b2 + hstep, voffB);
            PG8_WAIT_V(6); PG8_BAR; PG8_MMA(1, 1, At, B1); PG8_BAR;
            PG8_LDB(B0, 1, 0); PG8_SCHED; PG8_LDA(At, 1, 0); PG8_STAGE(PG8_SA(0, 1), a2 + hstepA, voffA);
            PG8_WAIT_L(8); PG8_BAR; PG8_WAIT_L(0); PG8_MMA(0, 0, At, B0); PG8_BAR; PG8_SCHED;
            PG8_LDB(B1, 1, 1); PG8_STAGE(PG8_SB(1, 0), b3, voffB);
            PG8_BAR; PG8_WAIT_L(0); PG8_MMA(0, 1, At, B1); PG8_BAR;
            PG8_LDA(At, 1, 1); PG8_STAGE(PG8_SA(1, 0), a3, voffA);
            PG8_BAR; PG8_WAIT_L(0); PG8_MMA(1, 0, At, B0); PG8_BAR; PG8_SCHED;
            PG8_STAGE(PG8_SB(1, 1), b3 + hstep, voffB);
            PG8_WAIT_V(6); PG8_BAR; PG8_MMA(1, 1, At, B1); PG8_BAR;
            }
        }
        if constexpr (FP8) asm volatile("s_nop 15\n\ts_nop 7" ::: "memory");
        if constexpr (ALIGN_EPI) { if (wr == 0) PG8_BAR; }
        if constexpr (!Epi::AFTER_DRAIN) { E(acc, cur, wr, wc, fr, fq); S.done(cur); }
        if (!has_next) break;
#pragma unroll
        for (int a = 0; a < 2; ++a)
#pragma unroll
            for (int b = 0; b < 2; ++b)
#pragma unroll
                for (int m = 0; m < 4; ++m)
#pragma unroll
                    for (int n = 0; n < 2; ++n) acc[a][b][m][n] = (f32x4){0.f, 0.f, 0.f, 0.f};
        cur = nxt; cA = nA; cB = nB; ++ui;
        if constexpr (ALIGN_EPI) { if (wr == 1) PG8_BAR; }
    }
    PG8_WAIT_V(0);
    if constexpr (!ALIGN_EPI) { if (wr == 0) PG8_BAR; }
    PG8_BAR;
    if constexpr (Epi::AFTER_DRAIN) { E.fused(acc, cur, wr, wc, fr, fq, lds, wid, lane); S.done(cur); }
#undef PG8_SA
#undef PG8_SB
#undef PG8_STAGE
#undef PG8_LDA
#undef PG8_LDB
#undef PG8_MMA
#undef PG8_WAIT_V
#undef PG8_WAIT_L
#undef PG8_BAR
#undef PG8_SCHED
}
}

typedef GAS unsigned gu32;
typedef GAS unsigned long long gu64;
#define RLX_AGENT __ATOMIC_RELAXED, __HIP_MEMORY_SCOPE_AGENT
#define LDS_WAIT() asm volatile("s_waitcnt lgkmcnt(0)" ::: "memory")
#define VM_WAIT() asm volatile("s_waitcnt vmcnt(0)" ::: "memory")
__device__ __forceinline__ unsigned long long rt() { return __builtin_amdgcn_s_memrealtime(); }

#define XB_TMO      128
#define XB_XCNT(j)  (256  + 64 * (j))
#define XB_XSUB(j)  (1280 + 64 * (j))
#define XB_XGEN(j)  (2304 + 64 * (j))
#define XB_TOP      3328
#define XB_TOPGEN   3392
#define XCD_BAR_WORDS 3456
#define XB_SPIN_CAP (1u << 18)

__device__ __forceinline__ unsigned xb_ld(unsigned* p)              { return __hip_atomic_load(p, __ATOMIC_RELAXED, __HIP_MEMORY_SCOPE_AGENT); }
__device__ __forceinline__ unsigned xb_add(unsigned* p, unsigned v) { return __hip_atomic_fetch_add(p, v, __ATOMIC_RELAXED, __HIP_MEMORY_SCOPE_AGENT); }
__device__ __forceinline__ unsigned xb_xcc_id() { return (unsigned)__builtin_amdgcn_s_getreg((3 << 11) | 20) & 0xFu; }
#define XB_SPIN(cond, bar) do { unsigned _sp = 0; while (cond) { __builtin_amdgcn_s_sleep(1); \
    if ((++_sp & 255u) == 0u) { if (xb_ld(&(bar)[XB_TMO])) break; if (_sp > XB_SPIN_CAP) { atomicAdd(&(bar)[XB_TMO], 1u); break; } } } } while (0)

struct XcdBarrier {
    unsigned* bar; unsigned x;
    volatile LAS unsigned* st;
};

__device__ __forceinline__ XcdBarrier xcd_barrier_post(unsigned* bar, volatile LAS unsigned* st) {
    XcdBarrier b; b.bar = bar; b.x = xb_xcc_id(); b.st = st;
    if (threadIdx.x == 0) (void)xb_add(&bar[XB_XCNT(b.x)], 1u);
    return b;
}
__device__ __forceinline__ void xcd_barrier_complete(unsigned* bar, unsigned x, unsigned& nloc, unsigned& nx) {
    const unsigned G = gridDim.x * gridDim.y * gridDim.z;
    unsigned sum, cnt, mine, sp = 0u;
    for (;;) {
        sum = 0u; cnt = 0u; mine = 0u;
#pragma unroll
        for (unsigned j = 0; j < 16; ++j) { const unsigned c = xb_ld(&bar[XB_XCNT(j)]); sum += c; cnt += (c > 0u) ? 1u : 0u; mine = (j == x) ? c : mine; }
        if (sum == G) break;
        __builtin_amdgcn_s_sleep(1);
        if ((++sp & 255u) == 0u) { if (xb_ld(&bar[XB_TMO])) break; if (sp > XB_SPIN_CAP) { atomicAdd(&bar[XB_TMO], 1u); break; } }
    }
    nloc = mine > 0u ? mine : 1u; nx = cnt > 0u ? cnt : 1u;
}

__device__ __forceinline__ void xcd_barrier(const XcdBarrier& b) {
    asm volatile("s_waitcnt vmcnt(0)" ::: "memory");
    __syncthreads();
    if (threadIdx.x == 0) {
        unsigned* bar = b.bar;
        __builtin_amdgcn_s_waitcnt(0);
        unsigned nloc = b.st[0], nx = b.st[1];
        if (nloc == 0u) { xcd_barrier_complete(bar, b.x, nloc, nx); b.st[0] = nloc; b.st[1] = nx; }
        const unsigned old = xb_add(&bar[XB_XSUB(b.x)], 1u);
        const unsigned gen = old / nloc;
        if (old + 1u == (gen + 1u) * nloc) {
            __builtin_amdgcn_fence(__ATOMIC_RELEASE, "agent");
            asm volatile("s_waitcnt vmcnt(0)" ::: "memory");
            const unsigned og = xb_add(&bar[XB_TOP], 1u);
            const unsigned tg = og / nx;
            if (og + 1u == (tg + 1u) * nx) xb_add(&bar[XB_TOPGEN], 1u);
            else XB_SPIN(xb_ld(&bar[XB_TOPGEN]) == tg, bar);
            __builtin_amdgcn_fence(__ATOMIC_ACQUIRE, "agent");
            xb_add(&bar[XB_XGEN(b.x)], 1u);
            asm volatile("s_waitcnt vmcnt(0)" ::: "memory");
        } else {
            XB_SPIN(xb_ld(&bar[XB_XGEN(b.x)]) == gen, bar);
            __builtin_amdgcn_fence(__ATOMIC_ACQUIRE, "agent");
            asm volatile("s_waitcnt vmcnt(0)" ::: "memory");
        }
    }
    __syncthreads();
}


struct Params {
    const float* x; const float* rel_bias; const float* ln_attn; const float* ln_mlp; const float* moba_w_qkv; const float* moba_w_o; const float* dsa_w_in; const float* dsa_g_q; const float* dsa_g_kv;
    const float* dsa_w_uq; const float* dsa_w_qi; const float* dsa_w_uk; const float* dsa_w_uv; const float* dsa_w_o; const float* mlp_w_up; const float* mlp_w_down; const float* final_norm;
    float* out; unsigned char* ws;
};
constexpr int NWAVES = 8, NTHR = NWAVES * 64;
constexpr int LDS_BYTES = 163840;
constexpr int LDSCTL_OFF = LDS_BYTES - 512;

__device__ __forceinline__ float wave_sum(float v) {
#pragma unroll
    for (int o = 1; o < 64; o <<= 1) v += __shfl_xor(v, o);
    return v;
}
__device__ __forceinline__ float wave_max(float v) {
#pragma unroll
    for (int o = 1; o < 64; o <<= 1) v = fmaxf(v, __shfl_xor(v, o));
    return v;
}

__device__ __forceinline__ void p0_transpose_item(const float* W, const float* gain, int K, int N, int Npad, bf16_t* WT, int row_off, LAS float* scr, int item, int lane) {
    const int nblk = Npad / 32, kb = item / nblk, nb = item % nblk, k0 = 64 * kb, n0 = 32 * nb;
    { const int n = n0 + (lane & 31); const bool nok = n < N; float v[32];
#pragma unroll
      for (int i = 0; i < 32; ++i) { const int kk = 2 * i + (lane >> 5); v[i] = nok ? W[(size_t)(k0 + kk) * N + n] : 0.f; }
      if (gain) {
#pragma unroll
          for (int i = 0; i < 32; ++i) v[i] *= gain[k0 + 2 * i + (lane >> 5)]; }
#pragma unroll
      for (int i = 0; i < 32; ++i) scr[(2 * i + (lane >> 5)) * 33 + (lane & 31)] = v[i]; }
    asm volatile("s_waitcnt lgkmcnt(0)" ::: "memory");
    const int c = lane & 7;
#pragma unroll
    for (int j = 0; j < 4; ++j) { const int n = (lane >> 3) + 8 * j; const LAS float* s = scr + (8 * c) * 33 + n;
        u32x4 o; o.x = pk2(s[0 * 33], s[1 * 33]); o.y = pk2(s[2 * 33], s[3 * 33]); o.z = pk2(s[4 * 33], s[5 * 33]); o.w = pk2(s[6 * 33], s[7 * 33]);
        *(u32x4*)(WT + (size_t)(row_off + n0 + n) * K + k0 + 8 * c) = o; }
    asm volatile("s_waitcnt lgkmcnt(0)" ::: "memory");
}
__device__ __forceinline__ void p0_transpose_item8(const float* W, const float* gain, int K, int N, unsigned char* WT, int row_off, LAS float* scr, int item, int lane) {
    const int nblk = N / 32, kb = item / nblk, nb = item % nblk, k0 = 64 * kb, n0 = 32 * nb;
    { const int n = n0 + (lane & 31); float v[32];
#pragma unroll
      for (int i = 0; i < 32; ++i) { const int kk = 2 * i + (lane >> 5); v[i] = W[(size_t)(k0 + kk) * N + n] * 16.0f; }
      if (gain) {
#pragma unroll
          for (int i = 0; i < 32; ++i) v[i] *= gain[k0 + 2 * i + (lane >> 5)]; }
#pragma unroll
      for (int i = 0; i < 32; ++i) scr[(2 * i + (lane >> 5)) * 33 + (lane & 31)] = v[i]; }
    asm volatile("s_waitcnt lgkmcnt(0)" ::: "memory");
    const int c = lane & 3;
#pragma unroll
    for (int j = 0; j < 2; ++j) { const int n = (lane >> 2) + 16 * j; const LAS float* s = scr + (16 * c) * 33 + n; u32x4 o;
#pragma unroll
        for (int q = 0; q < 4; ++q) { int t = __builtin_amdgcn_cvt_pk_fp8_f32(s[(4 * q) * 33], s[(4 * q + 1) * 33], 0, false); t = __builtin_amdgcn_cvt_pk_fp8_f32(s[(4 * q + 2) * 33], s[(4 * q + 3) * 33], t, true); o[q] = (unsigned)t; }
        *(u32x4*)(WT + (size_t)(row_off + n0 + n) * K + k0 + 16 * c) = o; }
    asm volatile("s_waitcnt lgkmcnt(0)" ::: "memory");
}
__device__ __forceinline__ void p0_prologue(const Params& P, LAS unsigned char* lds, int vcu, int G, int which) {
    const int tid = threadIdx.x, lane = tid & 63, wave = __builtin_amdgcn_readfirstlane(tid >> 6);
    unsigned char* ws = P.ws;
    LAS float* scr = (LAS float*)(lds + wave * 16384);
    const int gw = vcu * NWAVES + wave, NGW = G * NWAVES;
    constexpr int I_QKV = (DM / 64) * (3 * DM / 32), I_O = (DM / 64) * (DM / 32), I_UP = (DM / 64) * (FF / 32), I_DN = (FF / 64) * (DM / 32), I_IN = (DM / 64) * (DSA_IN_PAD / 32), I_QI = (DQ / 64) * (512 / 32);
    const bool do0 = which != 1, do1 = which != 0;
    if (do0) {
        constexpr int N0 = I_QKV + I_O + I_UP + I_DN + I_IN;
        for (int it = gw; it < N0; it += NGW) {
            int r = it;
            if (r < I_QKV) { p0_transpose_item8(P.moba_w_qkv, P.ln_attn, DM, 3 * DM, (unsigned char*)(ws + WS_WQKV0), 0, scr, r, lane); continue; } r -= I_QKV;
            if (r < I_O) { p0_transpose_item8(P.moba_w_o, nullptr, DM, DM, (unsigned char*)(ws + WS_WO0), 0, scr, r, lane); continue; } r -= I_O;
            if (r < I_UP) { p0_transpose_item(P.mlp_w_up, P.ln_mlp, DM, FF, FF, (bf16_t*)(ws + WS_WUP0), 0, scr, r, lane); continue; } r -= I_UP;
            if (r < I_DN) { p0_transpose_item(P.mlp_w_down, nullptr, FF, DM, DM, (bf16_t*)(ws + WS_WDN0), 0, scr, r, lane); continue; } r -= I_DN;
            p0_transpose_item(P.dsa_w_in, P.ln_attn + DM, DM, DSA_IN, DSA_IN_PAD, (bf16_t*)(ws + WS_WIN1), 0, scr, r, lane);
        }
    }
    if (do1) {
        constexpr int N1 = I_O + I_UP + I_DN + I_QI;
        for (int it = gw; it < N1; it += NGW) {
            int r = it;
            if (r < I_O) { p0_transpose_item8(P.dsa_w_o, nullptr, DM, DM, (unsigned char*)(ws + WS_WO1), 0, scr, r, lane); continue; } r -= I_O;
            if (r < I_UP) { p0_transpose_item(P.mlp_w_up + (size_t)DM * FF, P.ln_mlp + DM, DM, FF, FF, (bf16_t*)(ws + WS_WUP1), 0, scr, r, lane); continue; } r -= I_UP;
            if (r < I_DN) { p0_transpose_item8(P.mlp_w_down + (size_t)FF * DM, nullptr, FF, DM, (unsigned char*)(ws + WS_WDN1), 0, scr, r, lane); continue; } r -= I_DN;
            p0_transpose_item(P.dsa_w_qi, P.dsa_g_q, DQ, 512, 512, (bf16_t*)(ws + WS_WQI), 0, scr, r, lane);
        }
    }
    const int gt = vcu * NTHR + tid, NGT = G * NTHR;
    if (do1)
    for (int it = gt; it < NH * DC * (DQ / 16); it += NGT) {
        const int c = it & 255, h = (it >> 8) & 15, k16 = (it >> 12) * 16;
        float a[16];
#pragma unroll
        for (int i = 0; i < 16; ++i) a[i] = 0.f;
        const float* uk = P.dsa_w_uk + (size_t)h * HD * DC + c; const float* uq = P.dsa_w_uq + (size_t)k16 * DM + h * HD;
        for (int d = 0; d < HD; ++d) { const float w = uk[(size_t)d * DC];
#pragma unroll
            for (int i = 0; i < 16; ++i) a[i] += uq[(size_t)i * DM + d] * w; }
#pragma unroll
        for (int i = 0; i < 16; ++i) a[i] *= 16.0f * C2 * P.dsa_g_q[k16 + i];
        u32x4 o;
#pragma unroll
        for (int q = 0; q < 4; ++q) { int t = __builtin_amdgcn_cvt_pk_fp8_f32(a[4 * q], a[4 * q + 1], 0, false); t = __builtin_amdgcn_cvt_pk_fp8_f32(a[4 * q + 2], a[4 * q + 3], t, true); o[q] = (unsigned)t; }
        *(u32x4*)((unsigned char*)(ws + WS_WQ1) + (size_t)(h * DC + c) * DQ + k16) = o;
    }
    if (do1)
    for (int it = gt; it < DM * (DM / 16); it += NGT) {
        const int n = it & 1023, kl16 = (it >> 10) * 16, h = n >> 6, d = n & 63, hh = kl16 >> 8, c16 = kl16 & 255;
        u32x4 o = (u32x4){0u, 0u, 0u, 0u};
        if (hh == (h & 3)) { const float* uv = P.dsa_w_uv + ((size_t)h * DC + c16) * HD + d;
#pragma unroll
            for (int q = 0; q < 4; ++q) { int t = __builtin_amdgcn_cvt_pk_fp8_f32(16.0f * uv[(4 * q) * HD], 16.0f * uv[(4 * q + 1) * HD], 0, false); t = __builtin_amdgcn_cvt_pk_fp8_f32(16.0f * uv[(4 * q + 2) * HD], 16.0f * uv[(4 * q + 3) * HD], t, true); o[q] = (unsigned)t; } }
        *(u32x4*)((unsigned char*)(ws + WS_WUVB) + (size_t)n * DM + kl16) = o;
    }
    if (do0)
    for (int it = gt; it < 128 * NH; it += NGT) { const int d = it >> 4, h = it & 15; ((float*)(ws + WS_LUT))[it] = P.rel_bias[BUCKET_TAB[d] * NH + h] * LOG2E; }
    if (do0)
    for (int m0 = gw * 4; m0 < T; m0 += NGW * 4) {
        f32x4 v[4][4];
#pragma unroll
        for (int r = 0; r < 4; ++r)
#pragma unroll
            for (int j = 0; j < 4; ++j) v[r][j] = ((const f32x4*)(P.x + (size_t)(m0 + r) * DM) + lane)[64 * j];
#pragma unroll
        for (int r = 0; r < 4; ++r) { float s = 0.f; unsigned* o4 = (unsigned*)((unsigned char*)(ws + WS_XB) + (size_t)(m0 + r) * DM) + lane;
#pragma unroll
            for (int j = 0; j < 4; ++j) { s += sumsq4(v[r][j]); int t = __builtin_amdgcn_cvt_pk_fp8_f32(v[r][j][0], v[r][j][1], 0, false); t = __builtin_amdgcn_cvt_pk_fp8_f32(v[r][j][2], v[r][j][3], t, true); o4[64 * j] = (unsigned)t; }
            s = wave_sum(s);
            if (lane < 16) ((float*)(ws + WS_SSP))[(size_t)(m0 + r) * 16 + lane] = (lane == 0) ? s : 0.f; }
    }
}
__device__ __forceinline__ void ckv_norm(const Params& P, int vcu, int G) {
    const int tid = threadIdx.x, lane = tid & 63, wave = __builtin_amdgcn_readfirstlane(tid >> 6);
    const int gw = vcu * NWAVES + wave, NGW = G * NWAVES; unsigned char* ws = P.ws;
    const f32x4 g = ((const f32x4*)P.dsa_g_kv)[lane];
    for (int m = gw; m < T; m += NGW) {
        const f32x4 p = *(const f32x4*)((const float*)(ws + WS_SSQ) + (size_t)m * 8 + 4);
        const float rs = 1.0f / sqrtf(((p[0] + p[1]) + (p[2] + p[3])) * (1.0f / 256.0f) + EPS);
        const f32x4 v = ((const f32x4*)((const float*)(ws + WS_CKV) + (size_t)m * DC))[lane] * rs * g;
        int w = __builtin_amdgcn_cvt_pk_fp8_f32(v[0], v[1], 0, false); w = __builtin_amdgcn_cvt_pk_fp8_f32(v[2], v[3], w, true);
        ((unsigned*)((unsigned char*)(ws + WS_CKV8) + (size_t)m * DC))[lane] = (unsigned)w;
    }
}
__device__ __forceinline__ void final_norm(const Params& P, int vcu, int G) {
    const int tid = threadIdx.x, lane = tid & 63, wave = __builtin_amdgcn_readfirstlane(tid >> 6);
    const int gw = vcu * NWAVES + wave, NGW = G * NWAVES; unsigned char* ws = P.ws;
    f32x4 g[4];
#pragma unroll
    for (int j = 0; j < 4; ++j) g[j] = ((const f32x4*)P.final_norm)[lane + 64 * j];
    for (int m0 = gw * 4; m0 < T; m0 += NGW * 4) {
        u32x2 v[4][4]; float rs[4];
#pragma unroll
        for (int r = 0; r < 4; ++r) { rs[r] = pg8::row_rstd16((const float*)(ws + WS_SSP), m0 + r);
#pragma unroll
            for (int j = 0; j < 4; ++j) v[r][j] = ((const u32x2*)((const bf16_t*)(ws + WS_XB) + (size_t)(m0 + r) * DM) + lane)[64 * j]; }
#pragma unroll
        for (int r = 0; r < 4; ++r)
#pragma unroll
            for (int j = 0; j < 4; ++j) { const f32x4 x = (f32x4){bflo(v[r][j].x), bfhi(v[r][j].x), bflo(v[r][j].y), bfhi(v[r][j].y)};
                ((f32x4*)(P.out + (size_t)(m0 + r) * DM) + lane)[64 * j] = x * rs[r] * g[j]; }
    }
}

namespace moba {
typedef float f32x16 __attribute__((ext_vector_type(16)));
typedef int v8i __attribute__((ext_vector_type(8)));
typedef int v2i __attribute__((ext_vector_type(2)));
constexpr int SLOT = 4096;
constexpr int L_K = 0, L_V = 2 * SLOT, L_LUT = 4 * SLOT, L_OST = L_LUT + 2560, L_END = L_OST + 8 * 2048;
constexpr float NEGBIG = -1.0e30f;
__device__ __forceinline__ int crow(int r, int hi) { return (r & 3) + 8 * (r >> 2) + 4 * hi; }
__device__ __forceinline__ unsigned cvtpk(float lo, float hi) { typedef __bf16 bf2 __attribute__((ext_vector_type(2))); f32x2 v = {lo, hi}; bf2 b = __builtin_convertvector(v, bf2); return __builtin_bit_cast(unsigned, b); }
__device__ __forceinline__ int pk4(float a, float b, float c, float d) { int w = __builtin_amdgcn_cvt_pk_fp8_f32(a, b, 0, false); return __builtin_amdgcn_cvt_pk_fp8_f32(c, d, w, true); }
__device__ __forceinline__ f32x16 mma8(const v8i a, const v8i b, const f32x16 c, int sa, int sb) { return __builtin_amdgcn_mfma_scale_f32_32x32x64_f8f6f4(a, b, c, 0, 0, 0, sa, 0, sb); }

__device__ __forceinline__ void unit(const Params& P, LAS unsigned char* lds, int b, int h, int j) {
    const int tid = threadIdx.x, lane = tid & 63, r32 = lane & 31, hi = lane >> 5; const int wid = __builtin_amdgcn_readfirstlane(tid >> 6);
    unsigned char* ws = P.ws;
    const unsigned char* Q8 = (const unsigned char*)(ws + WS_BIG); const unsigned char* K8 = Q8 + (size_t)T * DM; const unsigned char* V8 = K8 + (size_t)T * DM;
    const size_t rowbase = (size_t)b * SEQ; const int q0 = j * MBLK;
    LAS float* lut = (LAS float*)(lds + L_LUT);
    __syncthreads();
    for (int t_ = tid; t_ < 640; t_ += NTHR) lut[t_] = (t_ < 128) ? NEGBIG : ((const float*)(ws + WS_LUT))[((t_ - 128) < 127 ? (t_ - 128) : 127) * NH + h];
    const int w4 = wid & 3, skey = 16 * w4 + (lane >> 2), spc = lane & 3, slc = spc ^ ((skey >> 2) & 3);
    const unsigned char* ssrc = (wid < 4 ? K8 : V8) + (rowbase + skey) * DM + h * HD + slc * 16;
    const int sdst = (wid < 4 ? L_K : L_V) + w4 * 1024;
    const int nt = 4 * (j + 1);
#define MOBA_TROW(i) (((i) < 4) ? (q0 + (i) * 64) : ((j - 1 - (((i) - 4) >> 2)) * MBLK + (((i) - 4) & 3) * 64))
#define MOBA_ISSUE(i) do { const int _tr = MOBA_TROW(i); \
        __builtin_amdgcn_global_load_lds((const unsigned*)(ssrc + (size_t)_tr * DM), (LAS unsigned*)(lds + sdst + ((i) & 1) * SLOT), 16, 0, 0); } while (0)
    MOBA_ISSUE(0);
    v8i qb;
    { const unsigned char* qp = Q8 + (rowbase + q0 + wid * 32 + r32) * DM + h * HD + 32 * hi; const u32x4 a = *(const u32x4*)qp, c = *(const u32x4*)(qp + 16);
      qb = (v8i){(int)a.x, (int)a.y, (int)a.z, (int)a.w, (int)c.x, (int)c.y, (int)c.z, (int)c.w}; }
    unsigned sel = 0u;
    if (j > 0) {
        f32x16 G;
#pragma unroll
        for (int r = 0; r < 16; ++r) G[r] = 0.f;
        const float* ks0 = (const float*)(ws + WS_KSUM) + ((size_t)((b * NBLK + r32) * 2)) * DM + h * HD + 32 * hi;
#pragma unroll
        for (int d0 = 0; d0 < 4; ++d0) {
            float kv[8];
            if (r32 < j) { const f32x4 a0 = *(const f32x4*)(ks0 + d0 * 8), a1 = *(const f32x4*)(ks0 + d0 * 8 + 4), c0 = *(const f32x4*)(ks0 + DM + d0 * 8), c1 = *(const f32x4*)(ks0 + DM + d0 * 8 + 4);
#pragma unroll
                for (int e = 0; e < 4; ++e) { kv[e] = a0[e] + c0[e]; kv[4 + e] = a1[e] + c1[e]; } }
            else {
#pragma unroll
                for (int e = 0; e < 8; ++e) kv[e] = 0.f; }
            bf16x8 ah, al;
#pragma unroll
            for (int e = 0; e < 8; ++e) { const unsigned hb = f2bf(kv[e]); ah[e] = (short)hb; al[e] = (short)f2bf(kv[e] - bf2f(hb)); }
            const f32x2 q01 = __builtin_amdgcn_cvt_pk_f32_fp8(qb[2 * d0], false), q23 = __builtin_amdgcn_cvt_pk_f32_fp8(qb[2 * d0], true), q45 = __builtin_amdgcn_cvt_pk_f32_fp8(qb[2 * d0 + 1], false), q67 = __builtin_amdgcn_cvt_pk_f32_fp8(qb[2 * d0 + 1], true);
            const u32x4 qw = {cvtpk(q01[0], q01[1]), cvtpk(q23[0], q23[1]), cvtpk(q45[0], q45[1]), cvtpk(q67[0], q67[1])};
            const bf16x8 qf = __builtin_bit_cast(bf16x8, qw);
            G = __builtin_amdgcn_mfma_f32_32x32x16_bf16(ah, qf, G, 0, 0, 0);
            G = __builtin_amdgcn_mfma_f32_32x32x16_bf16(al, qf, G, 0, 0, 0);
        }
        float a[8], bs[8], g16[16];
#pragma unroll
        for (int r = 0; r < 8; ++r) { a[r] = G[r]; bs[r] = __shfl_xor(a[r], 32); }
#pragma unroll
        for (int i = 0; i < 4; ++i) { g16[i] = hi ? bs[i] : a[i]; g16[4 + i] = hi ? a[i] : bs[i]; g16[8 + i] = hi ? bs[4 + i] : a[4 + i]; g16[12 + i] = hi ? a[4 + i] : bs[4 + i]; }
#pragma unroll
        for (int n = 0; n < 15; ++n) { if (n < j) { int rank = 0;
#pragma unroll
                for (int m = 0; m < 15; ++m) { if (m != n && m < j) rank += (g16[m] > g16[n] || (g16[m] == g16[n] && m < n)) ? 1 : 0; }
                if (rank < 3) sel |= 1u << n; } }
    }
    float m_ref = 0.f, lsum = 0.f; f32x16 o0, o1, cin;
#pragma unroll
    for (int r = 0; r < 16; ++r) { o0[r] = 0.f; o1[r] = 0.f; cin[r] = 0.f; }
    const int SC1 = 0x7F7F7F7F, SCQ = 0x7C7C7C7C;
    const int ksw = (r32 >> 2) & 3; const int kofa = r32 * 64 + (((2 * hi) ^ ksw) << 4), kofb = r32 * 64 + (((2 * hi + 1) ^ ksw) << 4);
    const int l15 = lane & 15, r8 = l15 >> 1, p2 = l15 & 1, dsel = (lane >> 4) & 1;
    const int vkey0 = (r8 & 3) + 8 * (r8 >> 2) + 4 * hi, vsw = (vkey0 >> 2) & 3;
    const int vof0 = vkey0 * 64 + ((dsel ^ vsw) << 4) + 8 * p2, vof1 = vkey0 * 64 + (((2 + dsel) ^ vsw) << 4) + 8 * p2;
    const float b31 = ((const float*)(ws + WS_LUT))[127 * NH + h];
    for (int i = 0; i < nt; ++i) {
        asm volatile("s_waitcnt vmcnt(0)" ::: "memory"); __syncthreads();
        if (i + 1 < nt) MOBA_ISSUE(i + 1);
        const bool own = i < 4; const int blk = own ? j : j - 1 - ((i - 4) >> 2); const int tt = own ? i : ((i - 4) & 3);
        const bool rowsel = own || ((sel >> blk) & 1u);
        const bool active = own ? (tt * 64 <= wid * 32 + 31) : (__any(rowsel) != 0);
        if (!active) continue;
        const bool near = own || (blk == j - 1 && tt >= 2);
        if (own || tt == 0 || (blk == j - 1 && tt == 2)) {
            const float cv = rowsel ? ((near ? 0.f : b31) - m_ref) : NEGBIG;
#pragma unroll
            for (int r = 0; r < 16; ++r) cin[r] = cv; }
        f32x16 p0, p1; float ts;
        const LAS unsigned char* kb = lds + L_K + (i & 1) * SLOT;
        const LAS float* lb = lut + ((j - blk) * MBLK + wid * 32 + r32 - tt * 64 + 128);
#define MOBA_SCORES() do { \
          const u32x4 a0 = *(const LAS u32x4*)(kb + kofa), a1 = *(const LAS u32x4*)(kb + kofb), c0 = *(const LAS u32x4*)(kb + 2048 + kofa), c1 = *(const LAS u32x4*)(kb + 2048 + kofb); \
          p0 = mma8((v8i){(int)a0.x, (int)a0.y, (int)a0.z, (int)a0.w, (int)a1.x, (int)a1.y, (int)a1.z, (int)a1.w}, qb, cin, SC1, SCQ); \
          p1 = mma8((v8i){(int)c0.x, (int)c0.y, (int)c0.z, (int)c0.w, (int)c1.x, (int)c1.y, (int)c1.z, (int)c1.w}, qb, cin, SC1, SCQ); \
          if (near) {                                                          \
              _Pragma("unroll") for (int r = 0; r < 16; ++r) { const float b0_ = lb[-crow(r, hi)], b1_ = lb[-crow(r, hi) - 32]; p0[r] = rowsel ? p0[r] + b0_ : NEGBIG; p1[r] = rowsel ? p1[r] + b1_ : NEGBIG; } } } while (0)
#define MOBA_EXPSUM() do { \
          _Pragma("unroll") for (int r = 0; r < 16; ++r) { p0[r] = __builtin_amdgcn_exp2f(p0[r]); p1[r] = __builtin_amdgcn_exp2f(p1[r]); } \
          f32x2 a2 = {0.f, 0.f}, b2 = {0.f, 0.f};                             \
          _Pragma("unroll") for (int r = 0; r < 16; r += 2) { a2 += (f32x2){p0[r], p0[r + 1]}; b2 += (f32x2){p1[r], p1[r + 1]}; } \
          a2 += b2; ts = a2[0] + a2[1]; } while (0)
        bool redo = (i == 0);
        if (!redo) { MOBA_SCORES(); MOBA_EXPSUM(); redo = __any(!(ts <= 400.0f)) != 0; }
        if (redo) {
            MOBA_SCORES();
#define MX3(a, b, c) __builtin_fmaxf(__builtin_fmaxf((a), (b)), (c))
            float mxa = MX3(p0[0], p0[1], p1[0]), mxb = MX3(p0[2], p0[3], p1[1]); mxa = MX3(mxa, p1[2], p1[3]);
#pragma unroll
            for (int r = 4; r < 16; r += 4) { mxa = MX3(mxa, p0[r], p0[r + 1]); mxb = MX3(mxb, p0[r + 2], p0[r + 3]); mxa = MX3(mxa, p1[r], p1[r + 1]); mxb = MX3(mxb, p1[r + 2], p1[r + 3]); }
#undef MX3
            float mx = fmaxf(mxa, mxb);
            { const auto rr = __builtin_amdgcn_permlane32_swap(__builtin_bit_cast(unsigned, mx), __builtin_bit_cast(unsigned, mx), false, false);
              mx = fmaxf(__builtin_bit_cast(float, (unsigned)rr[0]), __builtin_bit_cast(float, (unsigned)rr[1])); }
            const float dl = (i == 0) ? mx : fmaxf(mx, 0.f); m_ref += dl;
#pragma unroll
            for (int r = 0; r < 16; ++r) { p0[r] -= dl; p1[r] -= dl; cin[r] -= dl; }
            if (i != 0) { const float f = __builtin_amdgcn_exp2f(-dl); lsum *= f;
#pragma unroll
                for (int r = 0; r < 16; ++r) { o0[r] *= f; o1[r] *= f; } }
            MOBA_EXPSUM();
        }
#undef MOBA_SCORES
#undef MOBA_EXPSUM
        lsum += ts;
        const v8i pb = {pk4(p0[0], p0[1], p0[2], p0[3]), pk4(p0[4], p0[5], p0[6], p0[7]), pk4(p0[8], p0[9], p0[10], p0[11]), pk4(p0[12], p0[13], p0[14], p0[15]),
                        pk4(p1[0], p1[1], p1[2], p1[3]), pk4(p1[4], p1[5], p1[6], p1[7]), pk4(p1[8], p1[9], p1[10], p1[11]), pk4(p1[12], p1[13], p1[14], p1[15])};
        { const LAS unsigned char* vb = lds + L_V + (i & 1) * SLOT;
          const v2i x0 = __builtin_amdgcn_ds_read_tr8_b64_v2i32((LAS v2i*)(vb + vof0)), x1 = __builtin_amdgcn_ds_read_tr8_b64_v2i32((LAS v2i*)(vb + vof0 + 1024)),
                    x2 = __builtin_amdgcn_ds_read_tr8_b64_v2i32((LAS v2i*)(vb + vof0 + 2048)), x3 = __builtin_amdgcn_ds_read_tr8_b64_v2i32((LAS v2i*)(vb + vof0 + 3072));
          const v2i y0 = __builtin_amdgcn_ds_read_tr8_b64_v2i32((LAS v2i*)(vb + vof1)), y1 = __builtin_amdgcn_ds_read_tr8_b64_v2i32((LAS v2i*)(vb + vof1 + 1024)),
                    y2 = __builtin_amdgcn_ds_read_tr8_b64_v2i32((LAS v2i*)(vb + vof1 + 2048)), y3 = __builtin_amdgcn_ds_read_tr8_b64_v2i32((LAS v2i*)(vb + vof1 + 3072));
          o0 = mma8((v8i){x0[0], x0[1], x1[0], x1[1], x2[0], x2[1], x3[0], x3[1]}, pb, o0, SC1, SC1);
          o1 = mma8((v8i){y0[0], y0[1], y1[0], y1[1], y2[0], y2[1], y3[0], y3[1]}, pb, o1, SC1, SC1); }
    }
#undef MOBA_ISSUE
#undef MOBA_TROW
    float rl;
    { const auto rr = __builtin_amdgcn_permlane32_swap(__builtin_bit_cast(unsigned, lsum), __builtin_bit_cast(unsigned, lsum), false, false);
      rl = 1.0f / (__builtin_bit_cast(float, (unsigned)rr[0]) + __builtin_bit_cast(float, (unsigned)rr[1])); }
    LAS unsigned char* stg = lds + L_OST + wid * 2048;
#pragma unroll
    for (int r4 = 0; r4 < 4; ++r4) {
        *(LAS int*)(stg + r32 * 64 + 8 * r4 + 4 * hi) = pk4(o0[4 * r4] * rl, o0[4 * r4 + 1] * rl, o0[4 * r4 + 2] * rl, o0[4 * r4 + 3] * rl);
        *(LAS int*)(stg + r32 * 64 + 32 + 8 * r4 + 4 * hi) = pk4(o1[4 * r4] * rl, o1[4 * r4 + 1] * rl, o1[4 * r4 + 2] * rl, o1[4 * r4 + 3] * rl); }
    unsigned char* Ow = (unsigned char*)(ws + WS_O0) + (rowbase + q0 + wid * 32) * DM + h * HD;
#pragma unroll
    for (int i = 0; i < 2; ++i) { const int row = i * 16 + (lane >> 2), ch = lane & 3; const u32x4 v = *(const LAS u32x4*)(stg + row * 64 + ch * 16); *(u32x4*)(Ow + (size_t)row * DM + ch * 16) = v; }
}

__device__ __forceinline__ void phase(const Params& P, LAS unsigned char* lds, int vcu, int G) {
    for (int u = vcu; u < NB * NH * NBLK; u += G) {
        const int i = u >> 8, v = u & 255; const int bh = v >> 1, half = v & 1; const int base = 2 * (i >> 1) + half; const int qb = (i & 1) ? 15 - base : base;
        unit(P, lds, bh >> 4, bh & 15, qb);
    }
    __syncthreads();
}
}
namespace idx {
typedef float f32x16 __attribute__((ext_vector_type(16)));
__device__ __forceinline__ int wave_isum(int v) {
    v += __builtin_amdgcn_update_dpp(0, v, 0x111, 0xf, 0xf, true);
    v += __builtin_amdgcn_update_dpp(0, v, 0x112, 0xf, 0xf, true);
    v += __builtin_amdgcn_update_dpp(0, v, 0x114, 0xf, 0xf, true);
    v += __builtin_amdgcn_update_dpp(0, v, 0x118, 0xf, 0xf, true);
    return (__builtin_amdgcn_readlane(v, 15) + __builtin_amdgcn_readlane(v, 31)) + (__builtin_amdgcn_readlane(v, 47) + __builtin_amdgcn_readlane(v, 63));
}
__device__ __forceinline__ unsigned wave_umax(unsigned v) {
    unsigned t;
    t = (unsigned)__builtin_amdgcn_update_dpp(0, (int)v, 0x111, 0xf, 0xf, true); v = v > t ? v : t;
    t = (unsigned)__builtin_amdgcn_update_dpp(0, (int)v, 0x112, 0xf, 0xf, true); v = v > t ? v : t;
    t = (unsigned)__builtin_amdgcn_update_dpp(0, (int)v, 0x114, 0xf, 0xf, true); v = v > t ? v : t;
    t = (unsigned)__builtin_amdgcn_update_dpp(0, (int)v, 0x118, 0xf, 0xf, true); v = v > t ? v : t;
    const unsigned a = (unsigned)__builtin_amdgcn_readlane((int)v, 15), b = (unsigned)__builtin_amdgcn_readlane((int)v, 31), c = (unsigned)__builtin_amdgcn_readlane((int)v, 47), d = (unsigned)__builtin_amdgcn_readlane((int)v, 63);
    const unsigned ab = a > b ? a : b, cd = c > d ? c : d; return ab > cd ? ab : cd;
}
#define IDX_CNT4(ca, cb, xa, xb, xc, xd) asm volatile( \
    "v_sub_u32_e64 %2, %7, %6 clamp\n\tv_sub_u32_e64 %3, %8, %6 clamp\n\tv_sub_u32_e64 %4, %9, %6 clamp\n\tv_sub_u32_e64 %5, %10, %6 clamp\n\t" \
    "v_min_u32_e32 %2, 1, %2\n\tv_min_u32_e32 %3, 1, %3\n\tv_min_u32_e32 %4, 1, %4\n\tv_min_u32_e32 %5, 1, %5\n\t" \
    "v_add3_u32 %0, %0, %2, %3\n\tv_add3_u32 %1, %1, %4, %5" \
    : "+v"(ca), "+v"(cb), "=&v"(t0_), "=&v"(t1_), "=&v"(t2_), "=&v"(t3_) : "s"(cm1), "v"(xa), "v"(xb), "v"(xc), "v"(xd))
__device__ __forceinline__ int count_ge(const unsigned (&x)[64], unsigned cand_, int nreg) {
    const unsigned cm1 = (unsigned)__builtin_amdgcn_readfirstlane((int)cand_) - 1u;
    unsigned c0 = 0, c1 = 0, c2 = 0, c3 = 0; unsigned t0_, t1_, t2_, t3_;
#pragma unroll
    for (int g = 0; g < 8; ++g) { if (g * 8 < nreg) {
            IDX_CNT4(c0, c1, x[g * 8 + 0], x[g * 8 + 1], x[g * 8 + 2], x[g * 8 + 3]);
            IDX_CNT4(c2, c3, x[g * 8 + 4], x[g * 8 + 5], x[g * 8 + 6], x[g * 8 + 7]); } }
    return wave_isum((int)((c0 + c1) + (c2 + c3)));
}
__device__ __forceinline__ void load_q(const Params& P, int b, int tq, bf16x8 (&qa)[2][4], float (&wq)[2][16], int r32, int hi) {
    unsigned char* ws = P.ws; const size_t tok0 = (size_t)b * SEQ + tq * 8;
    const bf16_t* QIDX = (const bf16_t*)(ws + WS_QIDX); const float* WIDX = (const float*)(ws + WS_WIDX);
#pragma unroll
    for (int rt = 0; rt < 2; ++rt) {
        const bf16_t* qp = QIDX + (tok0 + 4 * rt + (r32 >> 3)) * 512 + (r32 & 7) * ID + 8 * hi;
#pragma unroll
        for (int d0 = 0; d0 < 4; ++d0) qa[rt][d0] = *(const bf16x8*)(qp + d0 * 16);
#pragma unroll
        for (int ql = 0; ql < 4; ++ql) { const f32x4 w4 = *(const f32x4*)(WIDX + (tok0 + 4 * rt + ql) * IH + 4 * hi);
#pragma unroll
            for (int rr = 0; rr < 4; ++rr) wq[rt][4 * ql + rr] = w4[rr]; }
    }
}
__device__ __forceinline__ void load_k0(const Params& P, int b, int tq, bf16x8 (&kn)[4], int wid, int r32, int hi) {
    const int ntile = (tq * 8 + 8 + 31) >> 5;
    if (wid < ntile) { const bf16_t* kp = (const bf16_t*)(P.ws + WS_KIDX) + (size_t)b * SEQ * ID + (size_t)wid * 2048 + hi * 256 + r32 * 8;
#pragma unroll
        for (int d0 = 0; d0 < 4; ++d0) kn[d0] = *(const bf16x8*)(kp + d0 * 512); }
}
__device__ __forceinline__ void unit(const Params& P, LAS unsigned char* lds, int b, int tq, bf16x8 (&qa)[2][4], float (&wq)[2][16], bf16x8 (&kn)[4], int bn, int tqn) {
    const int tid = threadIdx.x, lane = tid & 63, r32 = lane & 31, hi = lane >> 5; const int wid = __builtin_amdgcn_readfirstlane(tid >> 6);
    unsigned char* ws = P.ws;
    const int t0 = tq * 8; const size_t tok0 = (size_t)b * SEQ + t0;
    const bf16_t* QIDX = (const bf16_t*)(ws + WS_QIDX); const bf16_t* KIDX = (const bf16_t*)(ws + WS_KIDX) + (size_t)b * SEQ * ID; const float* WIDX = (const float*)(ws + WS_WIDX);
    LAS unsigned* sc = (LAS unsigned*)lds;
    __syncthreads();
    const int ntile = (t0 + 8 + 31) >> 5, ntile_pad = (ntile + 1) & ~1;
#ifndef REP_IDXSC
#define REP_IDXSC 1
#endif
    for (int rep_ = 0; rep_ < REP_IDXSC; ++rep_) {
    for (int kt = wid; kt < ntile_pad; kt += 8) {
        if (kt >= ntile) {
#pragma unroll
            for (int i = 0; i < 4; ++i) sc[(4 * hi + i) * SEQ + kt * 32 + r32] = 0u;
            continue; }
        bf16x8 kb[4];
#pragma unroll
        for (int d0 = 0; d0 < 4; ++d0) kb[d0] = kn[d0];
        if (kt + 8 < ntile) { const bf16_t* kp = KIDX + (size_t)(kt + 8) * 2048 + hi * 256 + r32 * 8;
#pragma unroll
            for (int d0 = 0; d0 < 4; ++d0) kn[d0] = *(const bf16x8*)(kp + d0 * 512); }
        f32x16 c0, c1;
#pragma unroll
        for (int r = 0; r < 16; ++r) { c0[r] = 0.f; c1[r] = 0.f; }
#pragma unroll
        for (int d0 = 0; d0 < 4; ++d0) { c0 = __builtin_amdgcn_mfma_f32_32x32x16_bf16(qa[0][d0], kb[d0], c0, 0, 0, 0); c1 = __builtin_amdgcn_mfma_f32_32x32x16_bf16(qa[1][d0], kb[d0], c1, 0, 0, 0); }
        float s[8];
#pragma unroll
        for (int ql = 0; ql < 4; ++ql) { float a0 = 0.f, a1 = 0.f;
#pragma unroll
            for (int rr = 0; rr < 4; ++rr) { a0 += wq[0][4 * ql + rr] * fmaxf(c0[4 * ql + rr], 0.f); a1 += wq[1][4 * ql + rr] * fmaxf(c1[4 * ql + rr], 0.f); }
            s[ql] = a0; s[4 + ql] = a1; }
        const int sk = kt * 32 + r32 - t0 - 4 * hi;
#pragma unroll
        for (int i = 0; i < 4; ++i) {
            const auto rr = __builtin_amdgcn_permlane32_swap(__builtin_bit_cast(unsigned, s[i]), __builtin_bit_cast(unsigned, s[4 + i]), false, false);
            const float v = (__builtin_bit_cast(float, (unsigned)rr[0]) + __builtin_bit_cast(float, (unsigned)rr[1])) + 0.0f;
            const unsigned u = __builtin_bit_cast(unsigned, v); const unsigned key = u ^ ((unsigned)((int)u >> 31) | 0x80000000u);
            sc[(4 * hi + i) * SEQ + kt * 32 + r32] = (sk <= i) ? key : 0u; }
    }
    }
    if (bn >= 0) { load_q(P, bn, tqn, qa, wq, r32, hi); load_k0(P, bn, tqn, kn, wid, r32, hi); }
    __syncthreads();
#ifndef REP_IDXSEL
#define REP_IDXSEL 1
#endif
    for (int rep2_ = 0; rep2_ < REP_IDXSEL; ++rep2_) {
    const int tl = t0 + wid; const int nvalid = tl + 1; const int nreg = ntile_pad >> 1;
    unsigned x[64];
#ifndef REP_SELA
#define REP_SELA 1
#define REP_SELB 1
#define REP_SELC 1
#endif
    for (int ra_ = 0; ra_ < REP_SELA; ++ra_)
    { const LAS unsigned* rowp = sc + wid * SEQ + lane;
#pragma unroll
      for (int g = 0; g < 8; ++g) {
          if (g * 8 < nreg) {
#pragma unroll
              for (int e = 0; e < 8; ++e) { const unsigned v = rowp[(g * 8 + e) * 64]; x[g * 8 + e] = (g * 8 + e < nreg) ? v : 0u; } }
          else {
#pragma unroll
              for (int e = 0; e < 8; ++e) x[g * 8 + e] = 0u; } } }
    unsigned mlo = 0u, mhi = 0u;
#define IDX_PUT(i, bal) do { const unsigned _bl = (unsigned)(bal), _bh = (unsigned)((bal) >> 32); asm volatile("s_nop 3\n\tv_writelane_b32 %0, %2, %4\n\tv_writelane_b32 %1, %3, %4" : "+v"(mlo), "+v"(mhi) : "s"(_bl), "s"(_bh), "i"(i)); } while (0)
    if (nvalid <= TOPK) {
#pragma unroll
        for (int i = 0; i < 4; ++i) { const unsigned long long bal = __ballot(x[i] != 0u); IDX_PUT(i, bal); }
    } else {
        unsigned mxk = 0u;
#pragma unroll
        for (int i = 0; i < 64; ++i) mxk = mxk > x[i] ? mxk : x[i];
        mxk = wave_umax(mxk);
        unsigned lo, hi; int c_hi; bool found; unsigned thr; float f_lo, f_hi; int last;
        for (int rb_ = 0; rb_ < REP_SELB; ++rb_) {
        lo = 1u; hi = mxk + 1u; c_hi = 0; found = false; thr = 0u; f_lo = (float)nvalid - 255.5f; f_hi = -255.5f; last = 0;
        if (mxk > 0x80000000u + (8u << 23)) { const unsigned cand = mxk - (8u << 23); const int c = count_ge(x, cand, nreg);
            if (c == TOPK) { found = true; thr = cand; } else if (c > TOPK) { lo = cand; f_lo = (float)c - 255.5f; } else { hi = cand; c_hi = c; f_hi = (float)c - 255.5f; } }
        while (!found && hi - lo > 1u) { const unsigned width = hi - lo; unsigned mid;
            if (width > (1u << 22)) mid = lo + (width >> 1);
            else { unsigned st = (unsigned)((float)width * (f_lo / (f_lo - f_hi))); st = st < 1u ? 1u : (st > width - 1u ? width - 1u : st); mid = lo + st; }
            mid = (unsigned)__builtin_amdgcn_readfirstlane((int)mid);
#ifdef PROBE_CNT2
            { int cdummy = count_ge(x, mid, nreg); asm volatile("" :: "s"(cdummy)); }
#endif
            const int c = count_ge(x, mid, nreg); const float f = (float)c - 255.5f;
            if (c == TOPK) { found = true; thr = mid; }
            else if (c > TOPK) { lo = mid; f_lo = f; if (last == 1) f_hi *= 0.5f; last = 1; }
            else { hi = mid; c_hi = c; f_hi = f; if (last == 2) f_lo *= 0.5f; last = 2; } }
        asm volatile("" : "+s"(lo), "+s"(hi) :: "memory");
        }
        for (int rc_ = 0; rc_ < REP_SELC; ++rc_)
#ifdef PROBE_K
        for (int pk_ = 0; pk_ < PROBE_K; ++pk_) { int cdummy = count_ge(x, lo + pk_, nreg); asm volatile("" :: "s"(cdummy)); }
#endif
        if (found) {
#pragma unroll
            for (int g = 0; g < 8; ++g) { if (g * 8 < nreg) {
#pragma unroll
                    for (int e = 0; e < 8; ++e) { const unsigned long long bal = __ballot(x[g * 8 + e] >= thr); IDX_PUT(g * 8 + e, bal); } } }
        } else {
            const unsigned tau = lo; const int need = TOPK - c_hi; int run = 0;
#pragma unroll
            for (int i = 0; i < 64; ++i) { const bool eq = x[i] == tau; const unsigned long long em = __ballot(eq); const int pre = run + __popcll(em & ((1ull << lane) - 1ull));
                const unsigned long long bal = __ballot(x[i] > tau || (eq && pre < need)); IDX_PUT(i, bal); run += __popcll(em); }
        }
    }
#undef IDX_PUT
    ((u32x2*)((unsigned*)(ws + WS_MASK) + (tok0 + wid) * 128))[lane] = (u32x2){mlo, mhi};
    }
}
__device__ __forceinline__ void phase(const Params& P, LAS unsigned char* lds, int vcu, int G) {
    const int lane = threadIdx.x & 63, r32 = lane & 31, hi = lane >> 5;
    bf16x8 qa[2][4], kn[4]; float wq[2][16]; const int wid = __builtin_amdgcn_readfirstlane(threadIdx.x >> 6);
#define IDX_DEC(u_, b_, tq_) const int b_ = ((u_) >> 8) >> 1, tq_ = (((u_) >> 8) & 1) ? 511 - ((u_) & 255) : ((u_) & 255)
    int u = vcu;
    if (u < T / 8) { IDX_DEC(u, b0, tq0); load_q(P, b0, tq0, qa, wq, r32, hi); load_k0(P, b0, tq0, kn, wid, r32, hi); }
    for (; u < T / 8; u += G) { IDX_DEC(u, b, tq); const int un = u + G; IDX_DEC(un, bnn, tqn); unit(P, lds, b, tq, qa, wq, kn, un < T / 8 ? bnn : -1, tqn); }
#undef IDX_DEC
    __syncthreads();
}
}
namespace dsa {
constexpr int W_STRIDE = 16384 + 640;
constexpr int L_LUT = 8 * W_STRIDE;
constexpr int L_END = L_LUT + 8192;
constexpr float NEGBIG = -1.0e30f;
typedef int v2i __attribute__((ext_vector_type(2)));
__device__ __forceinline__ int fswz(int r) { return (r < 8) ? 2 * r : 2 * ((r ^ 4) & 7) + 1; }
__device__ __forceinline__ int Fsw(int row) { return fswz(row & 15) ^ ((row >> 4) & 1); }
__device__ __forceinline__ unsigned cvtpk(float lo, float hi) { typedef __bf16 bf2 __attribute__((ext_vector_type(2))); f32x2 v = {lo, hi}; bf2 b = __builtin_convertvector(v, bf2); return __builtin_bit_cast(unsigned, b); }
__device__ __forceinline__ unsigned pk4_fp8(float a, float b, float c, float d) { int w = __builtin_amdgcn_cvt_pk_fp8_f32(a, b, 0, false); w = __builtin_amdgcn_cvt_pk_fp8_f32(c, d, w, true); return (unsigned)w; }
__device__ __forceinline__ long mk64(unsigned lo, unsigned hi) { return (long)(((unsigned long long)hi << 32) | (unsigned long long)lo); }

__device__ __forceinline__ void query(const Params& P, LAS unsigned char* wl, const LAS float* lut, const unsigned (&lcoff)[16], int b, int tl, int lane, bool dummy) {
    unsigned char* ws = P.ws;
    const int l15 = lane & 15, g = lane >> 4, q16 = lane >> 4;
    const size_t tok = (size_t)b * SEQ + tl;
    unsigned char* QL = (unsigned char*)(ws + WS_BIG) + tok * (size_t)(NH * DC);
    u32x4 srd_; (void)srd_;
    const __amdgpu_buffer_rsrc_t rsrc = __builtin_amdgcn_make_buffer_rsrc((void*)(ws + WS_CKV8 + (size_t)b * SEQ * DC), 0, SEQ * DC, 0x00020000);
    LAS unsigned short* il = (LAS unsigned short*)(wl + 16384);
    long qb[8];
#pragma unroll
    for (int p = 0; p < 4; ++p) { const u32x4 w = *(const u32x4*)(QL + l15 * DC + 64 * p + 16 * g); qb[2 * p] = mk64(w.x, w.y); qb[2 * p + 1] = mk64(w.z, w.w); }
    unsigned long long m = ((const unsigned long long*)((const unsigned*)(ws + WS_MASK) + tok * 128))[lane];
    const int cnt = __popcll(m); int inc = cnt;
#pragma unroll
    for (int o = 1; o < 64; o <<= 1) { const int v = __shfl_up(inc, o); if (lane >= o) inc += v; }
    int nsel = __builtin_amdgcn_readlane(inc, 63); nsel = nsel < TOPK ? nsel : TOPK;
    int pos = inc - cnt;
    while (m) { const int bit = __ffsll((long long)m) - 1; m &= m - 1; if (pos < TOPK) il[pos] = (unsigned short)(lane * 64 + bit); ++pos; }
    il[nsel + lane] = 0;
    asm volatile("s_waitcnt lgkmcnt(0)" ::: "memory");
    float m_run = 0.f; f32x4 o[16], lacc = (f32x4){0.f, 0.f, 0.f, 0.f};
#pragma unroll
    for (int ct = 0; ct < 16; ++ct) o[ct] = (f32x4){0.f, 0.f, 0.f, 0.f};
    const long ones = 0x3838383838383838L;
    const LAS unsigned char* abase = wl + l15 * 256;
    const int acst0 = (g ^ fswz(l15)) << 4, acst1 = acst0 ^ 16;
    const int r8 = l15 >> 1, p2 = l15 & 1; const int rowl = (r8 < 4) ? 4 * g + r8 : 16 + 4 * g + (r8 - 4);
    const LAS unsigned char* tbase = wl + rowl * 256 + 8 * p2;
    const int tcst = Fsw(rowl) << 4;
    const int nch = (nsel + 63) >> 6;
    const float b31h = lut[127 * NH + l15];
    for (int ch = 0; ch < nch; ++ch) {
        asm volatile("s_waitcnt lgkmcnt(0)" ::: "memory");
        const LAS unsigned short* ilc = il + ch * 64 + q16;
#pragma unroll
        for (int i = 0; i < 16; ++i) { const unsigned krow = ilc[4 * i];
            __builtin_amdgcn_raw_ptr_buffer_load_lds(rsrc, (LAS void*)(wl + i * 1024), 16, (krow << 8) + lcoff[i], 0, 0, 0); }
        const int kend = ch * 64 + 64; const int klast = (kend <= nsel ? kend : nsel) - 1;
        const int lastkey = __builtin_amdgcn_readfirstlane((int)il[klast]);
        const bool fast = (kend <= nsel) && (tl - lastkey >= 127);
        const float c_in = (fast ? b31h : 0.f) - m_run;
        f32x4 s[4];
#pragma unroll
        for (int t = 0; t < 4; ++t) s[t] = (f32x4){c_in, c_in, c_in, c_in};
        asm volatile("s_waitcnt vmcnt(0)" ::: "memory");
#pragma unroll
        for (int p = 0; p < 4; ++p)
#pragma unroll
            for (int t = 0; t < 4; ++t) { const u32x4 a = *(const LAS u32x4*)(abase + t * 4096 + ((p * 64) ^ ((t & 1) ? acst1 : acst0)));
                s[t] = __builtin_amdgcn_mfma_f32_16x16x32_fp8_fp8(mk64(a.x, a.y), qb[2 * p], s[t], 0, 0, 0);
                s[t] = __builtin_amdgcn_mfma_f32_16x16x32_fp8_fp8(mk64(a.z, a.w), qb[2 * p + 1], s[t], 0, 0, 0); }
        if (!fast) {
#pragma unroll
            for (int t = 0; t < 4; ++t)
#pragma unroll
                for (int e = 0; e < 4; ++e) { const int k0 = ch * 64 + 16 * t + 4 * g + e;
                    if (k0 < nsel) { const int d = tl - (int)il[k0]; s[t][e] += lut[(d < 127 ? d : 127) * NH + l15]; } else s[t][e] = NEGBIG; }
        }
        float mx = fmaxf(fmaxf(s[0][0], s[0][1]), fmaxf(s[0][2], s[0][3]));
#pragma unroll
        for (int t = 1; t < 4; ++t) mx = fmaxf(mx, fmaxf(fmaxf(s[t][0], s[t][1]), fmaxf(s[t][2], s[t][3])));
        { const auto r16 = __builtin_amdgcn_permlane16_swap(__builtin_bit_cast(unsigned, mx), __builtin_bit_cast(unsigned, mx), false, false);
          mx = fmaxf(__builtin_bit_cast(float, (unsigned)r16[0]), __builtin_bit_cast(float, (unsigned)r16[1]));
          const auto r32 = __builtin_amdgcn_permlane32_swap(__builtin_bit_cast(unsigned, mx), __builtin_bit_cast(unsigned, mx), false, false);
          mx = fmaxf(__builtin_bit_cast(float, (unsigned)r32[0]), __builtin_bit_cast(float, (unsigned)r32[1])); }
        if (ch == 0 || __any(mx > 8.0f)) {
            const float dl = (ch == 0) ? mx : fmaxf(mx, 0.f); m_run += dl;
#pragma unroll
            for (int t = 0; t < 4; ++t) s[t] = s[t] - dl;
            if (ch != 0) { const float alpha = __builtin_amdgcn_exp2f(-dl); lacc = lacc * alpha;
#pragma unroll
                for (int ct = 0; ct < 16; ++ct) o[ct] = o[ct] * alpha; }
        }
#pragma unroll
        for (int t = 0; t < 4; ++t)
#pragma unroll
            for (int e = 0; e < 4; ++e) s[t][e] = __builtin_amdgcn_exp2f(s[t][e]);
#pragma unroll
        for (int u = 0; u < 2; ++u) {
            const long pb = mk64(pk4_fp8(s[2 * u][0], s[2 * u][1], s[2 * u][2], s[2 * u][3]), pk4_fp8(s[2 * u + 1][0], s[2 * u + 1][1], s[2 * u + 1][2], s[2 * u + 1][3]));
            lacc = __builtin_amdgcn_mfma_f32_16x16x32_fp8_fp8(ones, pb, lacc, 0, 0, 0);
#pragma unroll
            for (int ct = 0; ct < 16; ++ct) { const v2i a = __builtin_amdgcn_ds_read_tr8_b64_v2i32((LAS v2i*)(tbase + u * 8192 + ((ct * 16) ^ tcst)));
                o[ct] = __builtin_amdgcn_mfma_f32_16x16x32_fp8_fp8(mk64((unsigned)a[0], (unsigned)a[1]), pb, o[ct], 0, 0, 0); }
        }
    }
    const float rl = 1.0f / lacc[0];
    unsigned char* OL = dummy ? (unsigned char*)(ws + WS_XB) + (tok & 8191) * (size_t)(NH * DC) : QL;
#pragma unroll
    for (int ct = 0; ct < 16; ++ct) { const f32x4 v = o[ct] * rl; *(unsigned*)(OL + l15 * DC + ct * 16 + 4 * g) = pk4_fp8(v[0], v[1], v[2], v[3]); }
}
__device__ __forceinline__ void phase(const Params& P, LAS unsigned char* lds, int vcu, int G) {
    const int tid = threadIdx.x, lane = tid & 63; const int wid = __builtin_amdgcn_readfirstlane(tid >> 6);
    LAS float* lut = (LAS float*)(lds + L_LUT);
    for (int i = tid; i < 128 * NH; i += NTHR) lut[i] = ((const float*)(P.ws + WS_LUT))[i];
    __syncthreads();
    LAS unsigned char* wl = lds + wid * W_STRIDE;
    unsigned lcoff[16];
#pragma unroll
    for (int i = 0; i < 16; ++i) lcoff[i] = (unsigned)(((lane & 15) ^ Fsw(4 * i + (lane >> 4))) << 4);
    const int gw = vcu * NWAVES + wid, NW = G * NWAVES;
    for (int q = gw; q < T; q += NW) { const int tl = (q >> 11) * 256 + (q & 255), b = (q >> 8) & 7;
#ifndef REP_DSA
#define REP_DSA 1
#endif
        for (int rep = 0; rep < REP_DSA; ++rep) query(P, wl, lut, lcoff, b, tl, lane, rep + 1 < REP_DSA); }
    __syncthreads();
}
}
constexpr int CW_BAR = 4096;
constexpr int MISC_OFF = LDSCTL_OFF + 64;
__device__ __forceinline__ int vcu_of(int bx, int G) { return (G % 8 == 0) ? (bx % 8) * (G / 8) + bx / 8 : bx; }

struct Args { Params P; int ph_lo, ph_hi, li, pad; };
constexpr int N_PHASES = 15;

template <int PH> __device__ __forceinline__ void gemm_ph(const Params& P, LAS unsigned char* L, int G, int bx) {
    unsigned char* ws = P.ws;
    bf16_t* XB = (bf16_t*)(ws + WS_XB); float* SSP = (float*)(ws + WS_SSP); bf16_t* BIG = (bf16_t*)(ws + WS_BIG);
    pg8::StaticOrder S;
    if constexpr (PH == 1) {
        pg8::Gemm g{XB, (const bf16_t*)(ws + WS_WQKV0), T, 3 * DM, DM / 2}; S.init(T, 3 * DM, G, bx);
        pg8::EpiQKV E{BIG, SSP, (float*)(ws + WS_KSUM)}; pg8::gemm_phase<pg8::EpiQKV, pg8::StaticOrder, true, true, true>(L, g, S, E);
    } else if constexpr (PH == 3) {
        pg8::Gemm g{(const bf16_t*)(ws + WS_O0), (const bf16_t*)(ws + WS_WO0), T, DM, DM / 2}; S.init(T, DM, G, bx);
        pg8::EpiRes<true, false> E{P.x, nullptr, XB, SSP}; pg8::gemm_phase<pg8::EpiRes<true, false>, pg8::StaticOrder, true, true, true>(L, g, S, E);
    } else if constexpr (PH == 4 || PH == 11) {
        pg8::Gemm g{XB, (const bf16_t*)(ws + (PH == 4 ? WS_WUP0 : WS_WUP1)), T, FF, DM}; S.init(T, FF, G, bx);
        pg8::EpiUp<PH == 11> E{BIG, SSP}; pg8::gemm_phase<pg8::EpiUp<PH == 11>, pg8::StaticOrder, true, true>(L, g, S, E);
    } else if constexpr (PH == 5) {
        pg8::Gemm g{BIG, (const bf16_t*)(ws + WS_WDN0), T, DM, FF}; S.init(T, DM, G, bx);
        pg8::EpiRes<false, false> E{nullptr, nullptr, XB, SSP}; pg8::gemm_phase<pg8::EpiRes<false, false>, pg8::StaticOrder, true, true>(L, g, S, E);
    } else if constexpr (PH == 12) {
        pg8::Gemm g{BIG, (const bf16_t*)(ws + WS_WDN1), T, DM, FF / 2}; S.init(T, DM, G, bx);
        pg8::EpiRes<false, false> E{nullptr, nullptr, XB, SSP}; pg8::gemm_phase<pg8::EpiRes<false, false>, pg8::StaticOrder, true, true, true>(L, g, S, E);
    } else if constexpr (PH == 6) {
        pg8::Gemm g{XB, (const bf16_t*)(ws + WS_WIN1), T, DSA_IN_PAD, DM}; S.init(T, DSA_IN_PAD, G, bx);
        pg8::EpiDsaIn E{(bf16_t*)(ws + WS_CQ), (float*)(ws + WS_CKV), (bf16_t*)(ws + WS_KIDX), (float*)(ws + WS_WIDX), (float*)(ws + WS_SSQ), SSP, (unsigned char*)(ws + WS_CQ8)};
        pg8::gemm_phase<pg8::EpiDsaIn, pg8::StaticOrder, true, true>(L, g, S, E);
    } else if constexpr (PH == 7) {
        pg8::Gemm g{(const bf16_t*)(ws + WS_CQ8), (const bf16_t*)(ws + WS_WQ1), T, NH * DC, DQ / 2}; S.init(T, NH * DC, G, bx);
        pg8::EpiDsaQ8 E{(unsigned char*)BIG, (const float*)(ws + WS_SSQ)}; pg8::gemm_phase<pg8::EpiDsaQ8, pg8::StaticOrder, true, true, true>(L, g, S, E);
    } else if constexpr (PH == 15) {
        pg8::Gemm g{(const bf16_t*)(ws + WS_CQ), (const bf16_t*)(ws + WS_WQI), T, 512, DQ}; S.init(T, 512, G, bx);
        pg8::EpiDsaQidx E{(bf16_t*)(ws + WS_QIDX), (const float*)(ws + WS_SSQ)}; pg8::gemm_phase<pg8::EpiDsaQidx, pg8::StaticOrder, true, true>(L, g, S, E);
    } else if constexpr (PH == 10) {
        pg8::Gemm g{BIG, (const bf16_t*)(ws + WS_WUVB), T, DM, DM / 2, NH * DC / 2, DM / 2}; S.init(T, DM, G, bx);
        pg8::EpiPlain8 E{(unsigned char*)(ws + WS_O0), DM}; pg8::gemm_phase<pg8::EpiPlain8, pg8::StaticOrder, true, true, true>(L, g, S, E);
    } else if constexpr (PH == 14) {
        pg8::Gemm g{(const bf16_t*)(ws + WS_O0), (const bf16_t*)(ws + WS_WO1), T, DM, DM / 2}; S.init(T, DM, G, bx);
        pg8::EpiRes<false, false> E{nullptr, nullptr, XB, SSP}; pg8::gemm_phase<pg8::EpiRes<false, false>, pg8::StaticOrder, true, true, true>(L, g, S, E);
    }
}

__global__ void __launch_bounds__(NTHR, 2) mega(Args args) {
    extern __shared__ __attribute__((aligned(16))) unsigned char lds[];
    LAS unsigned char* L = (LAS unsigned char*)lds;
    const Params& P = args.P;
    const int tid = threadIdx.x, G = gridDim.x, bx = blockIdx.x, vcu = vcu_of(bx, G);
    volatile LAS unsigned* MISC = (volatile LAS unsigned*)(L + MISC_OFF);
    for (int u = tid; u < (LDS_BYTES - LDSCTL_OFF) / 4; u += NTHR) ((LAS unsigned*)(L + LDSCTL_OFF))[u] = 0u;
    __syncthreads();
    gu32* ctl = (gu32*)(P.ws + WS_CTL);
    XcdBarrier bar = xcd_barrier_post((unsigned*)(ctl + CW_BAR) + args.li * XCD_BAR_WORDS, MISC + 8);
    const int lo = args.ph_lo, hi = args.ph_hi;
#define IN(k) (lo <= (k) && (k) < hi)
#define SEAM(k) do { if (IN(k) && IN((k) + 1)) xcd_barrier(bar); } while (0)
    const bool split_prep = (G == 256);
    if (IN(0)) { for (int rep = 0; rep < REP_PRO; ++rep) p0_prologue(P, L, vcu, G, split_prep ? 0 : 2); } SEAM(0);
    if (IN(1)) { gemm_ph<1>(P, L, G, bx); if (REP_QKV > 1) { __syncthreads(); gemm_ph<1>(P, L, G, bx); } } SEAM(1);
    if (IN(2)) { for (int rep = 0; rep < REP_MOBA; ++rep) moba::phase(P, L, vcu, G); } SEAM(2);
    if (IN(3)) { gemm_ph<3>(P, L, G, bx); } SEAM(3);
    if (IN(4)) { gemm_ph<4>(P, L, G, bx); if (REP_UP0 > 1) { __syncthreads(); gemm_ph<4>(P, L, G, bx); } } SEAM(4);
    if (IN(5)) { gemm_ph<5>(P, L, G, bx); } SEAM(5);
    if (IN(6)) { gemm_ph<6>(P, L, G, bx); if (split_prep && bx >= 128) p0_prologue(P, L, bx - 128, 128, 1); } SEAM(6);
    if (IN(7)) { ckv_norm(P, vcu, G); gemm_ph<7>(P, L, G, bx); gemm_ph<15>(P, L, G, bx);
#ifdef REP_QPROJ
        __syncthreads(); gemm_ph<7>(P, L, G, bx);
#endif
    } SEAM(7);
    if (IN(8)) { for (int rep = 0; rep < REP_IDX; ++rep) idx::phase(P, L, vcu, G); } SEAM(8);
    if (IN(9)) { dsa::phase(P, L, vcu, G); } SEAM(9);
    if (IN(10)) { gemm_ph<10>(P, L, G, bx); } SEAM(10);
    if (IN(11)) { gemm_ph<14>(P, L, G, bx); } SEAM(11);
    if (IN(12)) { gemm_ph<11>(P, L, G, bx); } SEAM(12);
    if (IN(13)) { gemm_ph<12>(P, L, G, bx); } SEAM(13);
    if (IN(14)) { final_norm(P, vcu, G); }
#undef IN
#undef SEAM
}

extern "C" void kernel_launch(void* const* d_in, const int* in_sizes, int n_in, void* d_out, int out_size, void* d_ws, size_t ws_size, hipStream_t stream) {
    static int grid = 0;
    if (grid == 0) {
        if (n_in != 17 || in_sizes[0] != T * DM || out_size != T * DM || ws_size < WS_END) { fprintf(stderr, "kernel_launch: unexpected shapes (n_in %d, in0 %d, out %d, ws %zu)\n", n_in, n_in > 0 ? in_sizes[0] : -1, out_size, ws_size); grid = -1; return; }
        int dev = 0, cus = 0;
        if (hipGetDevice(&dev) != hipSuccess || hipDeviceGetAttribute(&cus, hipDeviceAttributeMultiprocessorCount, dev) != hipSuccess) { grid = -1; return; }
        if (hipFuncSetAttribute((const void*)mega, hipFuncAttributeMaxDynamicSharedMemorySize, LDS_BYTES) != hipSuccess) { fprintf(stderr, "kernel_launch: hipFuncSetAttribute failed\n"); grid = -1; return; }
        (void)hipGetLastError();
        grid = cus;
    }
    if (grid < 0) return;
    if (hipMemsetAsync((char*)d_ws + WS_CTL, 0, CTL_ZERO_BYTES, stream) != hipSuccess) return;
    Args a{};
    Params& P = a.P;
    P.x = (const float*)d_in[0]; P.rel_bias = (const float*)d_in[1]; P.ln_attn = (const float*)d_in[2]; P.ln_mlp = (const float*)d_in[3]; P.moba_w_qkv = (const float*)d_in[4]; P.moba_w_o = (const float*)d_in[5];
    P.dsa_w_in = (const float*)d_in[6]; P.dsa_g_q = (const float*)d_in[7]; P.dsa_g_kv = (const float*)d_in[8]; P.dsa_w_uq = (const float*)d_in[9]; P.dsa_w_qi = (const float*)d_in[10]; P.dsa_w_uk = (const float*)d_in[11];
    P.dsa_w_uv = (const float*)d_in[12]; P.dsa_w_o = (const float*)d_in[13]; P.mlp_w_up = (const float*)d_in[14]; P.mlp_w_down = (const float*)d_in[15]; P.final_norm = (const float*)d_in[16];
    P.out = (float*)d_out; P.ws = (unsigned char*)d_ws;
    const dim3 g(grid), b(NTHR);
    a.ph_lo = 0; a.ph_hi = 15; a.li = 0; hipLaunchKernelGGL(mega, g, b, LDS_BYTES, stream, a);
}
```
